# Optimizing an MI355X kernel written in HIP

```python
import jax, jax.numpy as jnp
from jax import lax
import numpy as np

D_MODEL = 1024
BATCH = 16
SEQ = 2048
DEPTH = 1

D_MIX = D_MODEL
GLA_WIDTH = D_MIX // 2
DIFF_WIDTH = D_MIX - GLA_WIDTH
GLA_HEADS = 4
GLA_DV = GLA_WIDTH // GLA_HEADS
GLA_DK = GLA_DV // 2
GLA_RANK = 16
GLA_GATE_NORM = 16.0
GLA_CHUNK = 64
DIFF_HEADS = 4
DIFF_DV = DIFF_WIDTH // DIFF_HEADS
DIFF_DH = DIFF_DV // 2
Q_BLOCK = 128
EPS = 1e-6

SPLIT_SIZES = (
    GLA_HEADS * GLA_DK,
    GLA_HEADS * GLA_DK,
    GLA_WIDTH,
    GLA_WIDTH,
    GLA_RANK,
    DIFF_WIDTH,
    DIFF_WIDTH,
    DIFF_WIDTH,
    DIFF_WIDTH,
)
D_IN = sum(SPLIT_SIZES)

kernel_name = "hybrid_gla_diffattn_alibi_adaln"


def _rmsnorm(x, gain):
    xf = x.astype(jnp.float32)
    y = xf * lax.rsqrt(jnp.mean(xf * xf, axis=-1, keepdims=True) + EPS)
    return (y * gain.astype(jnp.float32)).astype(x.dtype)


def _gla_chunked(q, k, v, log_a):
    dtype = v.dtype
    B, S, H, DK = q.shape
    DV = v.shape[-1]
    N = S // GLA_CHUNK

    def chunks(t):
        return t.astype(jnp.float32).reshape(B, N, GLA_CHUNK, H, t.shape[-1]).transpose(1, 0, 3, 2, 4)

    q = chunks(q) * (DK ** -0.5)
    k, v, log_a = chunks(k), chunks(v), chunks(log_a)
    b = jnp.cumsum(log_a, axis=3)
    b_last = b[:, :, :, -1:, :]
    q_in = q * jnp.exp(b)
    k_in = k * jnp.exp(-b)
    k_st = k * jnp.exp(b_last - b)
    causal = jnp.tril(jnp.ones((GLA_CHUNK, GLA_CHUNK), dtype=bool))
    scores = jnp.einsum('nbhid,nbhjd->nbhij', q_in, k_in)
    intra = jnp.einsum('nbhij,nbhjv->nbhiv', jnp.where(causal, scores, 0.0), v)

    def step(state, inp):
        q_c, k_c, v_c, dec_c = inp
        out = jnp.einsum('bhik,bhkv->bhiv', q_c, state)
        state = dec_c[:, :, 0, :, None] * state + jnp.einsum('bhjk,bhjv->bhkv', k_c, v_c)
        return state, out

    state0 = jnp.zeros((B, H, DK, DV), jnp.float32)
    _, inter = lax.scan(step, state0, (q_in, k_st, v, jnp.exp(b_last)))
    o = (intra + inter).transpose(1, 0, 3, 2, 4).reshape(B, S, H, DV)
    return o.astype(dtype)


def _diff_attention(q, k, v, lam):
    B, S, H, _, DH = q.shape
    DV = v.shape[-1]
    nb = S // Q_BLOCK
    scale = DH ** -0.5
    slopes = 2.0 ** (-8.0 * jnp.arange(1, H + 1, dtype=jnp.float32) / H)
    kf = k.transpose(0, 2, 3, 1, 4)
    vf = v.transpose(0, 2, 1, 3)
    qb = q.reshape(B, nb, Q_BLOCK, H, 2, DH).transpose(1, 0, 3, 4, 2, 5)
    key_pos = jnp.arange(S)

    def block(args):
        q_blk, blk = args
        q_pos = blk * Q_BLOCK + jnp.arange(Q_BLOCK)
        dist = (q_pos[:, None] - key_pos[None, :]).astype(jnp.float32)
        bias = -slopes[:, None, None] * dist
        s = jnp.einsum('bhiqd,bhikd->bhiqk', q_blk, kf).astype(jnp.float32) * scale + bias[None, :, None]
        s = jnp.where(dist >= 0, s, -jnp.inf)
        p = jax.nn.softmax(s, axis=-1)
        w = p[:, :, 0] - lam * p[:, :, 1]
        return jnp.einsum('bhqk,bhkv->bhqv', w.astype(v.dtype), vf)

    out = lax.map(block, (qb, jnp.arange(nb)))
    return out.transpose(1, 0, 3, 2, 4).reshape(B, S, H, DV)


def setup_inputs(seed: int = 0) -> dict:
    key = jax.random.key(seed)
    ks = jax.random.split(key, 18)

    def nrm(k, shape, s):
        return jax.random.normal(k, shape, jnp.float32) * s

    return {
        "x": nrm(ks[0], (BATCH, SEQ, D_MODEL), 1.0),
        "c": nrm(ks[1], (BATCH, D_MODEL), 1.0),
        "w_ada": nrm(ks[2], (DEPTH, D_MODEL, 3 * D_MODEL), 0.5 * D_MODEL ** -0.5),
        "b_ada": nrm(ks[3], (DEPTH, 3 * D_MODEL), 0.02),
        "norm_gain": 1.0 + nrm(ks[4], (DEPTH, D_MODEL), 0.01),
        "w_in": nrm(ks[5], (DEPTH, D_MODEL, D_IN), D_MODEL ** -0.5),
        "w_gla_gate_up": nrm(ks[6], (DEPTH, GLA_RANK, GLA_HEADS * GLA_DK), GLA_RANK ** -0.5),
        "b_gla_gate": nrm(ks[7], (DEPTH, GLA_HEADS * GLA_DK), 0.1),
        "gla_out_gain": 1.0 + nrm(ks[8], (DEPTH, GLA_WIDTH), 0.01),
        "lambda_q1": nrm(ks[9], (DEPTH, DIFF_DH), 0.1),
        "lambda_k1": nrm(ks[10], (DEPTH, DIFF_DH), 0.1),
        "lambda_q2": nrm(ks[11], (DEPTH, DIFF_DH), 0.1),
        "lambda_k2": nrm(ks[12], (DEPTH, DIFF_DH), 0.1),
        "diff_out_gain": 1.0 + nrm(ks[13], (DEPTH, DIFF_WIDTH), 0.01),
        "w_out": nrm(ks[14], (DEPTH, D_MIX, D_MODEL), D_MIX ** -0.5),
        "final_gain": 1.0 + nrm(ks[15], (D_MODEL,), 0.01),
    }


def reference(x, c, w_ada, b_ada, norm_gain, w_in, w_gla_gate_up, b_gla_gate, gla_out_gain,
              lambda_q1, lambda_k1, lambda_q2, lambda_k2, diff_out_gain, w_out, final_gain):
    B, S, _ = x.shape
    split_points = [int(p) for p in np.cumsum(SPLIT_SIZES)[:-1]]
    for l in range(DEPTH):
        mod = jax.nn.silu(c) @ w_ada[l] + b_ada[l]
        shift, scale, gate = jnp.split(mod, 3, axis=-1)
        h = _rmsnorm(x, norm_gain[l]) * (1.0 + scale[:, None, :]) + shift[:, None, :]

        proj = h @ w_in[l]
        gq, gk, gv, gz, gr, dq, dk, dv, dz = jnp.split(proj, split_points, axis=-1)

        gate_logit = (gr @ w_gla_gate_up[l] + b_gla_gate[l]).astype(jnp.float32)
        log_a = jax.nn.log_sigmoid(gate_logit) / GLA_GATE_NORM
        o_gla = _gla_chunked(gq.reshape(B, S, GLA_HEADS, GLA_DK),
                             gk.reshape(B, S, GLA_HEADS, GLA_DK),
                             gv.reshape(B, S, GLA_HEADS, GLA_DV),
                             log_a.reshape(B, S, GLA_HEADS, GLA_DK))
        o_gla = _rmsnorm(o_gla, gla_out_gain[l].reshape(GLA_HEADS, GLA_DV)).reshape(B, S, GLA_WIDTH)
        o_gla = o_gla * jax.nn.silu(gz)

        lam_init = 0.8 - 0.6 * np.exp(-0.3 * l)
        lam = (jnp.exp(jnp.sum(lambda_q1[l] * lambda_k1[l])) - jnp.exp(jnp.sum(lambda_q2[l] * lambda_k2[l]))
               + lam_init).astype(jnp.float32)
        o_diff = _diff_attention(dq.reshape(B, S, DIFF_HEADS, 2, DIFF_DH),
                                 dk.reshape(B, S, DIFF_HEADS, 2, DIFF_DH),
                                 dv.reshape(B, S, DIFF_HEADS, DIFF_DV), lam)
        o_diff = _rmsnorm(o_diff, diff_out_gain[l].reshape(DIFF_HEADS, DIFF_DV)) * (1.0 - lam_init)
        o_diff = o_diff.reshape(B, S, DIFF_WIDTH) * jax.nn.silu(dz)

        mix = jnp.concatenate([o_gla, o_diff], axis=-1)
        x = x + gate[:, None, :] * (mix @ w_out[l])
    return _rmsnorm(x, final_gain)
```

```cpp
#include <hip/hip_runtime.h>
#include <hip/hip_cooperative_groups.h>
#include <cstdio>
#include <cstdint>
namespace cg = cooperative_groups;

typedef unsigned short bf16_t;
typedef short bf16x8 __attribute__((ext_vector_type(8)));
typedef float f32x4 __attribute__((ext_vector_type(4)));
typedef float f32x2 __attribute__((ext_vector_type(2)));
typedef __bf16 bf16v2 __attribute__((ext_vector_type(2)));
typedef unsigned u32x4 __attribute__((ext_vector_type(4)));
typedef unsigned u32x2 __attribute__((ext_vector_type(2)));

#define DI __device__ __forceinline__

constexpr int D_MODEL = 1024, BATCH = 16, SEQ = 2048, NTOK = BATCH * SEQ;
constexpr int D_IN = 3600, NP = 3584;
constexpr int C_GQ = 0, C_GK = 256, C_GV = 512, C_GZ = 1024, C_DQ = 1536, C_DK = 2048, C_DV = 2560, C_DZ = 3072;
constexpr int NTHREADS = 512;
constexpr int LDS_BYTES = 147456;
constexpr float EPS = 1e-6f;

struct Params {
  const float *x, *c, *w_ada, *b_ada, *norm_gain, *w_in, *w_up, *b_gate, *gla_gain, *lq1, *lk1, *lq2, *lk2, *diff_gain, *w_out, *final_gain;
  float* out;
  float* modpart;
  float* mod;
  float* rowsq;
  float* la;
  bf16_t* winT;
  bf16_t* woutT;
  bf16_t* h;
  bf16_t* proj;
  bf16_t* mix;
  bf16_t* gvT;
  bf16_t* dvT;
  unsigned* ctr;
  unsigned* bar;
  unsigned* pcnt;
  int phase_lo, phase_hi;
};

DI unsigned pk_bf16(float a, float b) { f32x2 v = {a, b}; bf16v2 r = __builtin_convertvector(v, bf16v2); return __builtin_bit_cast(unsigned, r); }
DI float bf_lo(unsigned u) { return __uint_as_float(u << 16); }
DI float bf_hi(unsigned u) { return __uint_as_float(u & 0xffff0000u); }
DI float bf2f(bf16_t u) { return __uint_as_float(((unsigned)u) << 16); }
DI float wave_sum(float v) {
#pragma unroll
  for (int o = 32; o >= 1; o >>= 1) v += __shfl_xor(v, o);
  return v;
}
DI float wave_max(float v) {
#pragma unroll
  for (int o = 32; o >= 1; o >>= 1) v = fmaxf(v, __shfl_xor(v, o));
  return v;
}
DI float silu_f(float v) { return v * __builtin_amdgcn_rcpf(1.f + __builtin_amdgcn_exp2f(-1.44269504f * v)); }

#define XB_TMO      128
#define XB_XCNT(j)  (256  + 64 * (j))
#define XB_XSUB(j)  (1280 + 64 * (j))
#define XB_XGEN(j)  (2304 + 64 * (j))
#define XB_TOP      3328
#define XB_TOPGEN   3392
#define XCD_BAR_WORDS 3456
#define XB_SPIN_CAP (1u << 20)
#define LAS __attribute__((address_space(3)))
DI unsigned xb_ld(unsigned* p)              { return __hip_atomic_load(p, __ATOMIC_RELAXED, __HIP_MEMORY_SCOPE_AGENT); }
DI unsigned xb_add(unsigned* p, unsigned v) { return __hip_atomic_fetch_add(p, v, __ATOMIC_RELAXED, __HIP_MEMORY_SCOPE_AGENT); }
DI unsigned xb_xcc_id() { return (unsigned)__builtin_amdgcn_s_getreg((3 << 11) | 20) & 0xFu; }
#define XB_SPIN(cond, bar) do { unsigned _sp = 0; while (cond) { __builtin_amdgcn_s_sleep(1); \
    if ((++_sp & 255u) == 0u) { if (xb_ld(&(bar)[XB_TMO])) break; if (_sp > XB_SPIN_CAP) { atomicAdd(&(bar)[XB_TMO], 1u); break; } } } } while (0)
DI void xcd_barrier_complete(unsigned* bar, unsigned x, unsigned& nloc, unsigned& nx) {
  const unsigned G = gridDim.x;
  unsigned sum, cnt, mine, sp = 0u;
  for (;;) {
    sum = 0u; cnt = 0u; mine = 0u;
#pragma unroll
    for (unsigned j = 0; j < 16; ++j) { const unsigned c = xb_ld(&bar[XB_XCNT(j)]); sum += c; cnt += (c > 0u) ? 1u : 0u; mine = (j == x) ? c : mine; }
    if (sum == G) break;
    __builtin_amdgcn_s_sleep(1);
    if ((++sp & 255u) == 0u) { if (xb_ld(&bar[XB_TMO])) break; if (sp > XB_SPIN_CAP) { atomicAdd(&bar[XB_TMO], 1u); break; } }
  }
  nloc = mine > 0u ? mine : 1u; nx = cnt > 0u ? cnt : 1u;
}
DI void xcd_barrier(unsigned* bar, volatile LAS unsigned* st) {
  asm volatile("s_waitcnt vmcnt(0)" ::: "memory");
  __syncthreads();
  if (threadIdx.x == 0) {
    const unsigned x = xb_xcc_id();
    __builtin_amdgcn_s_waitcnt(0);
    unsigned nloc = st[0], nx = st[1];
    if (nloc == 0u) { xcd_barrier_complete(bar, x, nloc, nx); st[0] = nloc; st[1] = nx; }
    const unsigned old = xb_add(&bar[XB_XSUB(x)], 1u);
    const unsigned gen = old / nloc;
    if (old + 1u == (gen + 1u) * nloc) {
      __builtin_amdgcn_fence(__ATOMIC_RELEASE, "agent");
      asm volatile("s_waitcnt vmcnt(0)" ::: "memory");
      const unsigned og = xb_add(&bar[XB_TOP], 1u);
      const unsigned tg = og / nx;
      if (og + 1u == (tg + 1u) * nx) xb_add(&bar[XB_TOPGEN], 1u);
      else XB_SPIN(xb_ld(&bar[XB_TOPGEN]) == tg, bar);
      __builtin_amdgcn_fence(__ATOMIC_ACQUIRE, "agent");
      xb_add(&bar[XB_XGEN(x)], 1u);
      asm volatile("s_waitcnt vmcnt(0)" ::: "memory");
    } else {
      XB_SPIN(xb_ld(&bar[XB_XGEN(x)]) == gen, bar);
      __builtin_amdgcn_fence(__ATOMIC_ACQUIRE, "agent");
      asm volatile("s_waitcnt vmcnt(0)" ::: "memory");
    }
  }
  __syncthreads();
}

DI int fresh_tid() { int t = threadIdx.x; asm volatile("" : "+v"(t)); return t; }

DI int perm32(int r) { return 8 * ((r & 15) >> 2) + 4 * (r >> 4) + (r & 3); }
DI int inv32(int a) { return ((a >> 2) & 1) * 16 + (a >> 3) * 4 + (a & 3); }

DI void phase0a(const Params& p, unsigned char* smem, const int t) {
  for (int i = blockIdx.x * NTHREADS + t; i < NTOK; i += gridDim.x * NTHREADS) p.rowsq[i] = 0.f;
  constexpr int N_MOD = 192, N_WIN = 16 * 56, N_WOUT = 16 * 16;
  for (int item = blockIdx.x; item < N_MOD + N_WIN + N_WOUT; item += gridDim.x) {
    __syncthreads();
    if (item < N_MOD) {
      const int nc = item % 24, ks = item / 24, n0 = nc * 128, k0 = ks * 128;
      float* sc = (float*)smem;
      float* red = sc + 16 * 128;
      for (int e = t; e < 2048; e += NTHREADS) { const int b = e >> 7, kk = e & 127; sc[e] = silu_f(p.c[b * 1024 + k0 + kk]); }
      __syncthreads();
      const int nl = t & 127, sub = t >> 7;
      float acc[16];
#pragma unroll
      for (int b = 0; b < 16; ++b) acc[b] = 0.f;
      for (int kk = sub * 32; kk < sub * 32 + 32; ++kk) {
        const float w = p.w_ada[(size_t)(k0 + kk) * 3072 + n0 + nl];
#pragma unroll
        for (int b = 0; b < 16; ++b) acc[b] += sc[b * 128 + kk] * w;
      }
#pragma unroll
      for (int b = 0; b < 16; ++b) red[(sub * 16 + b) * 128 + nl] = acc[b];
      __syncthreads();
      for (int e = t; e < 2048; e += NTHREADS) {
        const int b = e >> 7, n = e & 127;
        p.modpart[((size_t)ks * 16 + b) * 3072 + n0 + n] = red[(0 * 16 + b) * 128 + n] + red[(1 * 16 + b) * 128 + n] + red[(2 * 16 + b) * 128 + n] + red[(3 * 16 + b) * 128 + n];
      }
    } else {
      const float* src; bf16_t* dst; int ld, k0, n0, ncol;
      if (item < N_MOD + N_WIN) { const int it = item - N_MOD; k0 = (it % 16) * 64; n0 = (it / 16) * 64; src = p.w_in; ld = D_IN; dst = p.winT; ncol = n0 < C_DQ ? n0 : n0 + 16; }
      else { const int it = item - N_MOD - N_WIN; k0 = (it % 16) * 64; n0 = (it / 16) * 64; src = p.w_out; ld = 1024; dst = p.woutT; ncol = n0; }
      float* tile = (float*)smem;
#pragma unroll
      for (int e = 0; e < 8; ++e) { const int idx = e * NTHREADS + t, r = idx >> 6, cc = idx & 63; tile[r * 65 + cc] = src[(size_t)(k0 + r) * ld + ncol + cc]; }
      __syncthreads();
      const int n = t >> 3, ksg = (t & 7) * 8;
      const int ns = (src == p.w_in) ? ((n & ~31) | perm32(n & 31)) : n;
      u32x4 w;
      w.x = pk_bf16(tile[(ksg + 0) * 65 + ns], tile[(ksg + 1) * 65 + ns]);
      w.y = pk_bf16(tile[(ksg + 2) * 65 + ns], tile[(ksg + 3) * 65 + ns]);
      w.z = pk_bf16(tile[(ksg + 4) * 65 + ns], tile[(ksg + 5) * 65 + ns]);
      w.w = pk_bf16(tile[(ksg + 6) * 65 + ns], tile[(ksg + 7) * 65 + ns]);
      *(u32x4*)(dst + (size_t)(n0 + n) * 1024 + k0 + ksg) = w;
    }
  }
}

DI void phase0b(const Params& p, unsigned char* smem, const int t) {
  const int lane = t & 63, wid = t >> 6;
  for (int i = blockIdx.x * NTHREADS + t; i < 16 * 3072; i += gridDim.x * NTHREADS) {
    float s = p.b_ada[i % 3072];
#pragma unroll
    for (int ks = 0; ks < 8; ++ks) s += p.modpart[(size_t)ks * 16 * 3072 + i];
    p.mod[i] = s;
  }
  float* g = (float*)smem;
  float* sh = g + 1024;
  float* wg = sh + 1024;
  f32x4 wup[16];
#pragma unroll
  for (int r = 0; r < 16; ++r) wup[r] = *(const f32x4*)(p.w_up + r * 256 + lane * 4);
  const f32x4 bgv = *(const f32x4*)(p.b_gate + lane * 4);
  for (int item = blockIdx.x; item < NTOK / 128; item += gridDim.x) {
    const int b = item / 16, row0 = item * 128;
    __syncthreads();
    for (int k = t; k < 1024; k += NTHREADS) {
      float s_sh = p.b_ada[k], s_sc = p.b_ada[1024 + k];
#pragma unroll
      for (int ks = 0; ks < 8; ++ks) { s_sh += p.modpart[((size_t)ks * 16 + b) * 3072 + k]; s_sc += p.modpart[((size_t)ks * 16 + b) * 3072 + 1024 + k]; }
      g[k] = p.norm_gain[k] * (1.f + s_sc); sh[k] = s_sh;
    }
    for (int e = t; e < 16384; e += NTHREADS) { const int k = e >> 4, r = e & 15; wg[r * 1024 + k] = p.w_in[(size_t)k * D_IN + 1536 + r]; }
    __syncthreads();
    f32x4 xn[4];
#pragma unroll
    for (int i = 0; i < 4; ++i) xn[i] = *(const f32x4*)(p.x + (size_t)(row0 + wid) * 1024 + i * 256 + lane * 4);
    for (int rr = wid; rr < 128; rr += 8) {
      const size_t row = row0 + rr;
      const size_t hrow = (row & ~(size_t)31) | (size_t)inv32((int)(row & 31));
      f32x4 xv[4];
#pragma unroll
      for (int i = 0; i < 4; ++i) xv[i] = xn[i];
      if (rr + 8 < 128) {
#pragma unroll
        for (int i = 0; i < 4; ++i) xn[i] = *(const f32x4*)(p.x + (row + 8) * 1024 + i * 256 + lane * 4);
      }
      float ss = 0.f;
#pragma unroll
      for (int i = 0; i < 4; ++i) ss += xv[i][0] * xv[i][0] + xv[i][1] * xv[i][1] + xv[i][2] * xv[i][2] + xv[i][3] * xv[i][3];
      ss = wave_sum(ss);
      const float rstd = rsqrtf(ss * (1.f / 1024.f) + EPS);
      f32x2 pr2[16];
#pragma unroll
      for (int r = 0; r < 16; ++r) pr2[r] = (f32x2){0.f, 0.f};
#pragma unroll
      for (int i = 0; i < 4; ++i) {
        const int k = i * 256 + lane * 4;
        const f32x4 gv = *(const f32x4*)(g + k), sv = *(const f32x4*)(sh + k);
        const f32x4 hv = xv[i] * rstd * gv + sv;
        u32x2 w; w.x = pk_bf16(hv[0], hv[1]); w.y = pk_bf16(hv[2], hv[3]);
        *(u32x2*)(p.h + hrow * 1024 + k) = w;
        const f32x2 hlo = {hv[0], hv[1]}, hhi = {hv[2], hv[3]};
#pragma unroll
        for (int r = 0; r < 16; ++r) { const f32x4 wv = *(const f32x4*)(wg + r * 1024 + k); pr2[r] += hlo * (f32x2){wv[0], wv[1]}; pr2[r] += hhi * (f32x2){wv[2], wv[3]}; }
        __builtin_amdgcn_sched_barrier(0);
      }
      float pr[16];
#pragma unroll
      for (int r = 0; r < 16; ++r) pr[r] = pr2[r].x + pr2[r].y;
      float a8[8], a4[4], a2[2], a1;
      { const bool hi = lane & 1;
#pragma unroll
        for (int i = 0; i < 8; ++i) { const float keep = hi ? pr[i + 8] : pr[i], send = hi ? pr[i] : pr[i + 8]; a8[i] = keep + __shfl_xor(send, 1); } }
      { const bool hi = lane & 2;
#pragma unroll
        for (int i = 0; i < 4; ++i) { const float keep = hi ? a8[i + 4] : a8[i], send = hi ? a8[i] : a8[i + 4]; a4[i] = keep + __shfl_xor(send, 2); } }
      { const bool hi = lane & 4;
#pragma unroll
        for (int i = 0; i < 2; ++i) { const float keep = hi ? a4[i + 2] : a4[i], send = hi ? a4[i] : a4[i + 2]; a2[i] = keep + __shfl_xor(send, 4); } }
      { const bool hi = lane & 8; const float keep = hi ? a2[1] : a2[0], send = hi ? a2[0] : a2[1]; a1 = keep + __shfl_xor(send, 8); }
      a1 += __shfl_xor(a1, 16); a1 += __shfl_xor(a1, 32);
      float* grs = (float*)(smem + 73728) + wid * 16;
      if (lane < 16) grs[8 * (lane & 1) + 4 * ((lane >> 1) & 1) + 2 * ((lane >> 2) & 1) + ((lane >> 3) & 1)] = a1;
      const f32x4 g0 = *(const f32x4*)(grs), g1 = *(const f32x4*)(grs + 4), g2 = *(const f32x4*)(grs + 8), g3 = *(const f32x4*)(grs + 12);
      f32x4 lg = bgv;
#pragma unroll
      for (int j = 0; j < 4; ++j) {
        lg += g0[j] * wup[j] + g1[j] * wup[4 + j] + g2[j] * wup[8 + j] + g3[j] * wup[12 + j];
      }
      f32x4 lav;
#pragma unroll
      for (int j = 0; j < 4; ++j) lav[j] = (fminf(lg[j], 0.f) - __logf(1.f + __expf(-fabsf(lg[j])))) * (1.f / 16.f);
      *(f32x4*)(p.la + row * 256 + lane * 4) = lav;
    }
  }
}

constexpr int BM = 256, BK = 64, HALF = 128, NXCD = 8, WGM = 8, HT = HALF * BK;
DI int lds_byte(int r, int c) { int st = (r >> 4) * 2 + (c >> 5), rr = r & 15, cc = c & 31, ob = rr * 64 + cc * 2; return st * 1024 + (ob ^ (((ob >> 9) & 1) << 5)); }
DI void stage_rc(int b, int& R, int& C) { int st = b / 1024, sb = b % 1024, swz = sb ^ (((sb >> 9) & 1) << 5); R = (st >> 1) * 16 + swz / 64; C = (st & 1) * 32 + (swz % 64) / 2; }

template <class Epi>
DI void gemm_tile(const bf16_t* __restrict__ A, const bf16_t* __restrict__ Bt, const int K, const int brow, const int bcol, const Epi& epi) {
  extern __shared__ __attribute__((aligned(16))) unsigned char smem[];
  bf16_t* shm = (bf16_t*)smem;
#define SA(b, h) (shm + ((b) * 2 + (h)) * HT)
#define SB(b, h) (shm + (4 + (b) * 2 + (h)) * HT)
#define STAGE(P, BASE, br, kt) do { const bf16_t* _gb = (BASE) + ((long)(br) * K + (long)(kt) * BK); \
    __builtin_amdgcn_global_load_lds((const unsigned*)(_gb + toff0), (unsigned*)((char*)(P) + tb16), 16, 0, 0); \
    __builtin_amdgcn_global_load_lds((const unsigned*)(_gb + toff1), (unsigned*)((char*)(P) + tb16 + 8192), 16, 0, 0); } while (0)
#define LDA(dst, b, h) for (int m = 0; m < 4; ++m) for (int k = 0; k < 2; ++k) \
    dst[m][k] = *reinterpret_cast<const bf16x8*>(smem + a_base_ + (((b) * 2 + (h)) * 16384 + m * 2048 + k * 1024))
#define LDB(dst, b, h) for (int n = 0; n < 2; ++n) for (int k = 0; k < 2; ++k) \
    dst[n][k] = *reinterpret_cast<const bf16x8*>(smem + b_base_ + (((b) * 2 + (h)) * 16384 + n * 2048 + k * 1024))
#define MMA(ai, bj, At, Bt_) do { __builtin_amdgcn_s_setprio(1); \
    for (int m = 0; m < 4; ++m) for (int n = 0; n < 2; ++n) for (int k = 0; k < 2; ++k) \
      acc[ai][bj][m][n] = __builtin_amdgcn_mfma_f32_16x16x32_bf16(Bt_[n][k], At[m][k], acc[ai][bj][m][n], 0, 0, 0); \
    __builtin_amdgcn_s_setprio(0); } while (0)
#define WAIT_V(n) asm volatile("s_waitcnt vmcnt(" #n ")" ::: "memory")
#define WAIT_L(n) asm volatile("s_waitcnt lgkmcnt(" #n ")" ::: "memory")
#define BAR __builtin_amdgcn_s_barrier()
#define SCHED __builtin_amdgcn_sched_barrier(0)
  const int tid = fresh_tid();
  const int wid = tid >> 6, lane = tid & 63, wr = wid >> 2, wc = wid & 3, fr = lane & 15, fq = lane >> 4;
  const int tb16 = tid * 16;
  const unsigned a_base = (unsigned)lds_byte(wr * 64 + fr, fq * 8), b_base = 65536u + (unsigned)lds_byte(wc * 32 + fr, fq * 8);
  unsigned a_base_ = a_base, b_base_ = b_base; asm volatile("" : "+v"(a_base_), "+v"(b_base_));
  unsigned toff0, toff1;
  { int r0, c0, r1, c1; stage_rc(tb16, r0, c0); stage_rc(tb16 + 8192, r1, c1); toff0 = (unsigned)(r0 * K + c0); toff1 = (unsigned)(r1 * K + c1); }
  f32x4 acc[2][2][4][2] = {};
  bf16x8 At[4][2], B0[2][2], B1[2][2];
  const int nt = K / BK;
  STAGE(SB(0, 0), Bt, bcol, 0); STAGE(SA(0, 0), A, brow, 0);
  STAGE(SB(0, 1), Bt, bcol + HALF, 0); STAGE(SA(0, 1), A, brow + HALF, 0);
  if (wr == 1) BAR;
  WAIT_V(4); BAR;
  STAGE(SB(1, 0), Bt, bcol, 1); STAGE(SA(1, 0), A, brow, 1); STAGE(SB(1, 1), Bt, bcol + HALF, 1);
  WAIT_V(6); BAR;
  for (int t = 0; t < nt - 2; t += 2) {
    LDB(B0, 0, 0); SCHED; LDA(At, 0, 0); STAGE(SA(1, 1), A, brow + HALF, t + 1);
    WAIT_L(8); BAR; WAIT_L(0); MMA(0, 0, At, B0); BAR; SCHED;
    LDB(B1, 0, 1); STAGE(SB(0, 0), Bt, bcol, t + 2);
    BAR; WAIT_L(0); MMA(0, 1, At, B1); BAR;
    LDA(At, 0, 1); STAGE(SA(0, 0), A, brow, t + 2);
    BAR; WAIT_L(0); MMA(1, 0, At, B0); BAR; SCHED;
    STAGE(SB(0, 1), Bt, bcol + HALF, t + 2);
    WAIT_V(6); BAR; MMA(1, 1, At, B1); BAR;
    LDB(B0, 1, 0); SCHED; LDA(At, 1, 0); STAGE(SA(0, 1), A, brow + HALF, t + 2);
    WAIT_L(8); BAR; WAIT_L(0); MMA(0, 0, At, B0); BAR; SCHED;
    LDB(B1, 1, 1); STAGE(SB(1, 0), Bt, bcol, t + 3);
    BAR; WAIT_L(0); MMA(0, 1, At, B1); BAR;
    LDA(At, 1, 1); STAGE(SA(1, 0), A, brow, t + 3);
    BAR; WAIT_L(0); MMA(1, 0, At, B0); BAR; SCHED;
    STAGE(SB(1, 1), Bt, bcol + HALF, t + 3);
    WAIT_V(6); BAR; MMA(1, 1, At, B1); BAR;
  }
  { LDB(B0, 0, 0); LDA(At, 0, 0); STAGE(SA(1, 1), A, brow + HALF, nt - 1);
    BAR; WAIT_L(0); MMA(0, 0, At, B0); BAR;
    LDB(B1, 0, 1); BAR; WAIT_L(0); MMA(0, 1, At, B1); BAR;
    LDA(At, 0, 1); WAIT_V(4); BAR; WAIT_L(0); MMA(1, 0, At, B0); MMA(1, 1, At, B1); BAR; }
  { LDB(B0, 1, 0); LDA(At, 1, 0); WAIT_V(2); BAR; WAIT_L(0); MMA(0, 0, At, B0); BAR;
    LDB(B1, 1, 1); WAIT_V(0); BAR; WAIT_L(0); MMA(0, 1, At, B1); BAR;
    LDA(At, 1, 1); BAR; WAIT_L(0); MMA(1, 0, At, B0); MMA(1, 1, At, B1); BAR; }
  if (wr == 0) BAR;
  { int tid2 = threadIdx.x; asm volatile("" : "+v"(tid2));
    const int wid2 = tid2 >> 6, lane2 = tid2 & 63;
    epi(acc, brow, bcol, (wid2 >> 2) * 64, lane2 & 15, (wid2 & 3) * 32 + (lane2 >> 4) * 8, lane2); }
#undef SA
#undef SB
#undef STAGE
#undef LDA
#undef LDB
#undef MMA
}

DI bool tile_order(int i, int G, int c, int nM, int nN, int& pm, int& pn) {
  const int nwg = nM * nN; const long L = (long)i * G + c; if (L >= nwg) return false;
  int wgid = (int)L; { const int q = nwg / NXCD, r = nwg % NXCD, xcd = wgid % NXCD, off = wgid / NXCD; wgid = (xcd < r ? xcd * (q + 1) : r * (q + 1) + (xcd - r) * q) + off; }
  const int nig = WGM * nN, gid = wgid / nig, fm = gid * WGM, gsz = (nM - fm) < WGM ? (nM - fm) : WGM;
  pm = fm + ((wgid % nig) % gsz); pn = (wgid % nig) / gsz; return true;
}

struct EpiProj {
  bf16_t* O; bf16_t* gvT; bf16_t* dvT; int vmode;
  DI void operator()(f32x4 (&acc)[2][2][4][2], int brow, int bcol, int rw, int fr, int cw, int lane) const {
    const int rperm = 8 * (fr >> 2) + (fr & 3);
    if (vmode == 0) {
      const bool sil = (bcol >= C_GZ && bcol < C_DQ) || (bcol >= C_DZ);
#pragma unroll
      for (int ai = 0; ai < 2; ++ai)
#pragma unroll
        for (int m = 0; m < 4; ++m) {
          const int row = brow + ai * HALF + rw + (m >> 1) * 32 + 4 * (m & 1) + rperm;
          bf16_t* rp = O + (size_t)row * NP + bcol + cw;
#pragma unroll
          for (int bj = 0; bj < 2; ++bj) {
            f32x4 v0 = acc[ai][bj][m][0], v1 = acc[ai][bj][m][1];
            if (sil) {
#pragma unroll
              for (int j = 0; j < 4; ++j) { v0[j] = silu_f(v0[j]); v1[j] = silu_f(v1[j]); }
            }
            u32x4 w; w.x = pk_bf16(v0[0], v0[1]); w.y = pk_bf16(v0[2], v0[3]); w.z = pk_bf16(v1[0], v1[1]); w.w = pk_bf16(v1[2], v1[3]);
            *(u32x4*)(rp + bj * HALF) = w;
          }
        }
    } else {
      bf16_t* T = (vmode == 1) ? gvT : dvT;
      const int vbase = brow - ((vmode == 1) ? C_GV : C_DV);
      const int b = bcol / SEQ, s0 = bcol % SEQ + cw;
#pragma unroll
      for (int ai = 0; ai < 2; ++ai)
#pragma unroll
        for (int m = 0; m < 4; ++m) {
          const int v = vbase + ai * HALF + rw + (m >> 1) * 32 + 4 * (m & 1) + rperm;
          bf16_t* rp = T + ((size_t)b * 512 + v) * SEQ + s0;
#pragma unroll
          for (int bj = 0; bj < 2; ++bj) {
            const f32x4 v0 = acc[ai][bj][m][0], v1 = acc[ai][bj][m][1];
            u32x4 w; w.x = pk_bf16(v0[0], v0[1]); w.y = pk_bf16(v0[2], v0[3]); w.z = pk_bf16(v1[0], v1[1]); w.w = pk_bf16(v1[2], v1[3]);
            *(u32x4*)(rp + bj * HALF) = w;
          }
        }
    }
  }
};
struct EpiOut {
  const float* x; const float* mod; const float* fgain; float* out; float* rowsq; unsigned* pcnt;
  DI void operator()(f32x4 (&acc)[2][2][4][2], int brow, int bcol, int rw, int fr, int cwp, int lane) const {
    extern __shared__ __attribute__((aligned(16))) unsigned char smem[];
    constexpr int TS = 1040;
    const int b = brow / SEQ, wid = threadIdx.x >> 6;
    const int cw = (cwp & ~31) + ((cwp & 31) >> 1);
    f32x4 gt[2][2];
#pragma unroll
    for (int bj = 0; bj < 2; ++bj)
#pragma unroll
      for (int n = 0; n < 2; ++n) gt[bj][n] = *(const f32x4*)(mod + (size_t)b * 3072 + 2048 + bcol + cw + bj * HALF + n * 16);
    f32x4 Y[2][16];
    float myss[2] = {0.f, 0.f};
    __syncthreads();
#pragma unroll
    for (int ai = 0; ai < 2; ++ai) {
      const float* xb = x + (size_t)(brow + ai * HALF + wid * 16) * 1024 + bcol + lane * 4;
#pragma unroll
      for (int i = 0; i < 16; ++i) Y[ai][i] = *(const f32x4*)(xb + (size_t)i * 1024);
#pragma unroll
      for (int m = 0; m < 4; ++m)
#pragma unroll
        for (int bj = 0; bj < 2; ++bj)
#pragma unroll
          for (int n = 0; n < 2; ++n)
            *(f32x4*)(smem + (rw + m * 16 + fr) * TS + (bj * HALF + cw + n * 16) * 4) = gt[bj][n] * acc[ai][bj][m][n];
      __syncthreads();
#pragma unroll
      for (int i = 0; i < 16; ++i) {
        const f32x4 v = *(const f32x4*)(smem + (wid * 16 + i) * TS + lane * 16);
        const f32x4 y = Y[ai][i] + v; Y[ai][i] = y;
        const float ss = wave_sum(y[0] * y[0] + y[1] * y[1] + y[2] * y[2] + y[3] * y[3]);
        if (lane == i) myss[ai] = ss;
      }
      __syncthreads();
    }
    if (lane < 16) {
      (void)__hip_atomic_fetch_add(rowsq + (size_t)(brow + wid * 16 + lane), myss[0], __ATOMIC_RELAXED, __HIP_MEMORY_SCOPE_AGENT);
      (void)__hip_atomic_fetch_add(rowsq + (size_t)(brow + HALF + wid * 16 + lane), myss[1], __ATOMIC_RELAXED, __HIP_MEMORY_SCOPE_AGENT);
    }
    asm volatile("s_waitcnt vmcnt(0)" ::: "memory");
    __syncthreads();
    if (threadIdx.x == 0) {
      unsigned* c = pcnt + (brow >> 8);
      (void)__hip_atomic_fetch_add(c, 1u, __ATOMIC_RELAXED, __HIP_MEMORY_SCOPE_AGENT);
      unsigned sp = 0;
      while (__hip_atomic_load(c, __ATOMIC_RELAXED, __HIP_MEMORY_SCOPE_AGENT) < 4u) { __builtin_amdgcn_s_sleep(1); if (++sp > (1u << 22)) break; }
    }
    __syncthreads();
    float rn[2] = {0.f, 0.f};
    if (lane < 16) {
      rn[0] = rsqrtf(__hip_atomic_load(rowsq + (size_t)(brow + wid * 16 + lane), __ATOMIC_RELAXED, __HIP_MEMORY_SCOPE_AGENT) * (1.f / 1024.f) + EPS);
      rn[1] = rsqrtf(__hip_atomic_load(rowsq + (size_t)(brow + HALF + wid * 16 + lane), __ATOMIC_RELAXED, __HIP_MEMORY_SCOPE_AGENT) * (1.f / 1024.f) + EPS);
    }
    const f32x4 fg = *(const f32x4*)(fgain + bcol + lane * 4);
#pragma unroll
    for (int ai = 0; ai < 2; ++ai) {
      float* ob = out + (size_t)(brow + ai * HALF + wid * 16) * 1024 + bcol + lane * 4;
#pragma unroll
      for (int i = 0; i < 16; ++i) __builtin_nontemporal_store(Y[ai][i] * __shfl(rn[ai], i) * fg, (f32x4*)(ob + (size_t)i * 1024));
    }
  }
};

DI void gemm1_phase(const Params& p) {
  for (int i = 0;; ++i) {
    int pm, pn; if (!tile_order(i, gridDim.x, blockIdx.x, NTOK / BM, NP / BM, pm, pn)) break;
    const int vmode = (pn == 2 || pn == 3) ? 1 : ((pn == 10 || pn == 11) ? 2 : 0);
    const bf16_t* A = vmode ? p.winT : p.h; const bf16_t* Bt = vmode ? p.h : p.winT;
    const int brow = vmode ? pn * BM : pm * BM, bcol = vmode ? pm * BM : pn * BM;
    gemm_tile(A, Bt, 1024, brow, bcol, EpiProj{p.proj, p.gvT, p.dvT, vmode});
  }
}
DI void gemm2_phase(const Params& p) {
  for (int i = 0;; ++i) {
    int pm, pn; if (!tile_order(i, gridDim.x, blockIdx.x, NTOK / BM, 1024 / BM, pm, pn)) break;
    gemm_tile(p.mix, p.woutT, 1024, pm * BM, pn * BM, EpiOut{p.x, p.mod, p.final_gain, p.out, p.rowsq, p.pcnt});
  }
}

DI float lam_value(const Params& p, const int t) {
  const int i = t & 63;
  const float s1 = wave_sum(p.lq1[i] * p.lk1[i]), s2 = wave_sum(p.lq2[i] * p.lk2[i]);
  return __expf(s1) - __expf(s2) + 0.2f;
}

#define LBAR() do { asm volatile("s_waitcnt lgkmcnt(0)" ::: "memory"); __builtin_amdgcn_s_barrier(); asm volatile("" ::: "memory"); } while (0)

typedef float f32x16 __attribute__((ext_vector_type(16)));
#define MFMA32(a, b, c) __builtin_amdgcn_mfma_f32_32x32x16_bf16((a), (b), (c), 0, 0, 0)
constexpr int AT_KB = 16384, AT_VB = 16384, AT_BUF = AT_KB + AT_VB;

DI bf16x8 pack8(const f32x16& x, int s) {
  u32x4 p; p.x = pk_bf16(x[8 * s], x[8 * s + 1]); p.y = pk_bf16(x[8 * s + 2], x[8 * s + 3]); p.z = pk_bf16(x[8 * s + 4], x[8 * s + 5]); p.w = pk_bf16(x[8 * s + 6], x[8 * s + 7]);
  return __builtin_bit_cast(bf16x8, p);
}
DI int swap23(int x) { return (x & ~12) | ((x & 4) << 1) | ((x & 8) >> 1); }

constexpr int AT_K0 = 0, AT_V0 = 49152;
DI void attn_item(const Params& p, const int bh, const int qb, const float lam, unsigned char* smem, const int t) {
  const int lane = t & 63, wid = t >> 6, r32 = lane & 31, hl = lane >> 5;
  const int qg = wid & 3, mp = wid >> 2;
  const int b = bh >> 2, hd = bh & 3;
  const size_t tokb = (size_t)b * SEQ;
  const int q0 = qb * 128 + qg * 32, iq = q0 + r32;
  const float slope2 = exp2f(-2.f * (hd + 1)) * 1.44269504f;
  const f32x2 c1v = {0.125f * 1.44269504f, 0.125f * 1.44269504f};
  bf16x8 qf[4];
  {
    const bf16_t* qp = p.proj + (tokb + iq) * NP + C_DQ + hd * 128 + mp * 64 + hl * 8;
#pragma unroll
    for (int sl = 0; sl < 4; ++sl) qf[sl] = *(const bf16x8*)(qp + sl * 16);
  }
  f32x2 kb[8];
#pragma unroll
  for (int i = 0; i < 8; ++i) { const int kof = 16 * ((2 * i) >> 3) + ((2 * i) & 7) + 8 * hl; kb[i] = (f32x2){slope2 * (float)kof, slope2 * (float)(kof + 1)}; }
  f32x16 O[4];
#pragma unroll
  for (int dt = 0; dt < 4; ++dt)
#pragma unroll
    for (int r = 0; r < 16; ++r) O[dt][r] = 0.f;
  float mrun = 0.f, lrun = 0.f;
  const int L0 = wid * 128 + lane, L1 = L0 + 64;
  const int kr0 = L0 >> 4, kr1 = L1 >> 4;
  const bf16_t* kg0 = p.proj + (tokb + kr0) * NP + C_DK + hd * 128 + (((L0 & 15) ^ (kr0 & 15)) << 3);
  const bf16_t* kg1 = p.proj + (tokb + kr1) * NP + C_DK + hd * 128 + (((L1 & 15) ^ (kr1 & 15)) << 3);
  const int vr0 = L0 >> 3, vr1 = L1 >> 3;
  const bf16_t* vg0 = p.dvT + ((size_t)bh * 128 + vr0) * SEQ + (((L0 & 7) ^ ((vr0 >> 1) & 7)) << 3);
  const bf16_t* vg1 = p.dvT + ((size_t)bh * 128 + vr1) * SEQ + (((L1 & 7) ^ ((vr1 >> 1) & 7)) << 3);
  const unsigned wslot = wid * 2048;
#define AT_STAGE(kbo, vbo, jt_) do { \
    __builtin_amdgcn_global_load_lds((const unsigned*)(kg0 + (size_t)(jt_) * 64 * NP), (unsigned*)(smem + (kbo) + wslot), 16, 0, 0); \
    __builtin_amdgcn_global_load_lds((const unsigned*)(kg1 + (size_t)(jt_) * 64 * NP), (unsigned*)(smem + (kbo) + wslot + 1024), 16, 0, 0); \
    __builtin_amdgcn_global_load_lds((const unsigned*)(vg0 + (jt_) * 64), (unsigned*)(smem + (vbo) + wslot), 16, 0, 0); \
    __builtin_amdgcn_global_load_lds((const unsigned*)(vg1 + (jt_) * 64), (unsigned*)(smem + (vbo) + wslot + 1024), 16, 0, 0); } while (0)
  const int krow = swap23(r32);
  const unsigned kread = (krow * 256) | ((((krow & 15) ^ hl) << 4) ^ (mp << 7));
  const unsigned vread = r32 * 128 + ((hl ^ ((r32 >> 1) & 7)) << 4);
  const int nt = 2 * qb + 2, wnt = 2 * qb + (qg >> 1) + 1;
#define AT_QK(kbuf_) do { \
    bf16x8 kq0[4], kq1[4]; \
    _Pragma("unroll") for (int sl = 0; sl < 4; ++sl) { \
      kq0[sl] = *(const bf16x8*)((kbuf_) + (kread ^ (unsigned)((sl * 2) << 4))); \
      kq1[sl] = *(const bf16x8*)((kbuf_) + 8192 + (kread ^ (unsigned)((sl * 2) << 4))); } \
    _Pragma("unroll") for (int r = 0; r < 16; ++r) { S0[r] = 0.f; S1[r] = 0.f; } \
    __builtin_amdgcn_sched_barrier(0); \
    _Pragma("unroll") for (int sl = 0; sl < 4; ++sl) { S0 = MFMA32(kq0[sl], qf[sl], S0); S1 = MFMA32(kq1[sl], qf[sl], S1); } } while (0)
#define AT_SOFTMAX(DIAG) do { \
    const int dj = jt * 64 + 8 * hl - iq; \
    const float dls = slope2 * (float)(jt * 64 - iq) - mrun; \
    const f32x2 dl0 = {dls, dls}, dl1 = {dls + slope2 * 32.f, dls + slope2 * 32.f}; \
    float mx = -1e30f; \
    _Pragma("unroll") for (int i = 0; i < 8; ++i) { \
      const int kof = 16 * ((2 * i) >> 3) + ((2 * i) & 7); \
      f32x2 u0 = (f32x2){S0[2 * i], S0[2 * i + 1]} * c1v + (kb[i] + dl0), u1 = (f32x2){S1[2 * i], S1[2 * i + 1]} * c1v + (kb[i] + dl1); \
      if (DIAG) { if (dj + kof > 0) u0.x = -1e30f; if (dj + kof + 1 > 0) u0.y = -1e30f; if (dj + 32 + kof > 0) u1.x = -1e30f; if (dj + 33 + kof > 0) u1.y = -1e30f; } \
      S0[2 * i] = u0.x; S0[2 * i + 1] = u0.y; S1[2 * i] = u1.x; S1[2 * i + 1] = u1.y; \
      mx = fmaxf(fmaxf(mx, u0.x), fmaxf(u0.y, fmaxf(u1.x, u1.y))); } \
    mx = fmaxf(mx, __shfl_xor(mx, 32)); \
    live = first || !__all(mx < -60.f);     \
    if (!live) break; \
    if (__any(mx > 8.f) || first) { \
      const float inc = first ? mx : fmaxf(mx, 0.f), al = first ? 0.f : __builtin_amdgcn_exp2f(-inc);     \
      mrun += inc; lrun *= al; \
      _Pragma("unroll") for (int dt = 0; dt < 4; ++dt) _Pragma("unroll") for (int r = 0; r < 16; ++r) O[dt][r] *= al; \
      _Pragma("unroll") for (int r = 0; r < 16; ++r) { S0[r] -= inc; S1[r] -= inc; } } \
    f32x2 ls2 = {0.f, 0.f}; \
    _Pragma("unroll") for (int i = 0; i < 8; ++i) { \
      const f32x2 p0 = {__builtin_amdgcn_exp2f(S0[2 * i]), __builtin_amdgcn_exp2f(S0[2 * i + 1])}, p1 = {__builtin_amdgcn_exp2f(S1[2 * i]), __builtin_amdgcn_exp2f(S1[2 * i + 1])}; \
      S0[2 * i] = p0.x; S0[2 * i + 1] = p0.y; S1[2 * i] = p1.x; S1[2 * i + 1] = p1.y; ls2 += p0 + p1; } \
    lrun += ls2.x + ls2.y; \
    pf[0] = pack8(S0, 0); pf[1] = pack8(S0, 1); pf[2] = pack8(S1, 0); pf[3] = pack8(S1, 1); } while (0)
#define AT_VLD(dst, vbuf_, ks) _Pragma("unroll") for (int dt = 0; dt < 4; ++dt) dst[dt] = *(const bf16x8*)((vbuf_) + dt * 4096 + (vread ^ (unsigned)((ks) << 5)))
#define AT_VMM(src, ks) _Pragma("unroll") for (int dt = 0; dt < 4; ++dt) O[dt] = MFMA32(src[dt], pf[ks], O[dt])
#define AT_PV(vbuf_) do { \
    bf16x8 va[4], vb[4]; \
    AT_VLD(va, vbuf_, 0); AT_VLD(vb, vbuf_, 1); \
    __builtin_amdgcn_sched_barrier(0); \
    __builtin_amdgcn_s_setprio(1); \
    AT_VMM(va, 0); AT_VLD(va, vbuf_, 2); \
    __builtin_amdgcn_sched_barrier(0); \
    AT_VMM(vb, 1); AT_VLD(vb, vbuf_, 3); \
    __builtin_amdgcn_sched_barrier(0); \
    AT_VMM(va, 2); AT_VMM(vb, 3); \
    __builtin_amdgcn_s_setprio(0); } while (0)
  f32x16 S0, S1;
  bf16x8 pf[4];
  int kcur = 0;
  bool live = false, pend = false;
  __syncthreads();
  AT_STAGE(AT_K0, AT_V0, nt - 1);
  AT_STAGE(AT_K0 + 16384, AT_V0 + 16384, nt - 2);
  asm volatile("s_waitcnt vmcnt(4)" ::: "memory");
  LBAR();
  for (int it = 0; it < nt; ++it) {
    const int jt = nt - 1 - it;
    const bool first = (jt == wnt - 1);
    unsigned char* kbuf = smem + AT_K0 + kcur * 16384;
    unsigned char* vbuf = smem + AT_V0 + (it & 3) * 16384;
    const int k2 = (kcur == 0) ? 2 : kcur - 1;
    if (it + 2 < nt) AT_STAGE(AT_K0 + k2 * 16384, AT_V0 + ((it + 2) & 3) * 16384, jt - 2);
    if (mp == 0) {
      if (jt < wnt) {
        AT_QK(kbuf);
        if (jt * 64 + 63 > q0) AT_SOFTMAX(1); else AT_SOFTMAX(0);
        if (live) AT_PV(vbuf);
      }
    } else {
      if (jt < wnt) AT_QK(kbuf);
      if (pend) AT_PV(smem + AT_V0 + ((it - 1) & 3) * 16384);
      pend = false;
      if (jt < wnt) { if (jt * 64 + 63 > q0) AT_SOFTMAX(1); else AT_SOFTMAX(0); pend = live; }
    }
    kcur = (kcur == 2) ? 0 : kcur + 1;
    if (it + 2 < nt) asm volatile("s_waitcnt vmcnt(4)" ::: "memory"); else asm volatile("s_waitcnt vmcnt(0)" ::: "memory");
    LBAR();
  }
  if (mp == 1 && pend) AT_PV(smem + AT_V0 + ((nt - 1) & 3) * 16384);
  __syncthreads();
#undef AT_STAGE
#undef AT_QK
#undef AT_SOFTMAX
#undef AT_PV
#undef AT_VLD
#undef AT_VMM
  const float lt = lrun + __shfl_xor(lrun, 32);
  const float sc = (mp ? lam : 1.f) / lt;
  float* xch = (float*)(smem + qg * 16384);
  if (mp == 1) {
#pragma unroll
    for (int dt = 0; dt < 4; ++dt)
#pragma unroll
      for (int g = 0; g < 4; ++g)
        *(f32x4*)(xch + ((dt * 4 + g) * 64 + lane) * 4) = (f32x4){O[dt][4 * g] * sc, O[dt][4 * g + 1] * sc, O[dt][4 * g + 2] * sc, O[dt][4 * g + 3] * sc};
  }
  __syncthreads();
  if (mp == 0) {
    float ss = 0.f;
#pragma unroll
    for (int dt = 0; dt < 4; ++dt)
#pragma unroll
      for (int g = 0; g < 4; ++g) {
        const f32x4 o2 = *(const f32x4*)(xch + ((dt * 4 + g) * 64 + lane) * 4);
#pragma unroll
        for (int j = 0; j < 4; ++j) { const float o = O[dt][4 * g + j] * sc - o2[j]; O[dt][4 * g + j] = o; ss += o * o; }
      }
    ss += __shfl_xor(ss, 32);
    const float rn = rsqrtf(ss * (1.f / 128.f) + EPS) * 0.8f;
    const bf16_t* zp = p.proj + (tokb + iq) * NP + C_DZ + hd * 128 + 4 * hl;
    bf16_t* mo = p.mix + (tokb + iq) * 1024 + 512 + hd * 128 + 4 * hl;
    const float* gp = p.diff_gain + hd * 128 + 4 * hl;
#pragma unroll
    for (int dt = 0; dt < 4; ++dt)
#pragma unroll
      for (int g = 0; g < 4; ++g) {
        const int dv = dt * 32 + 8 * g;
        const u32x2 zz = *(const u32x2*)(zp + dv); const f32x4 gn = *(const f32x4*)(gp + dv);
        const float y0 = O[dt][4 * g + 0] * rn * gn[0] * bf_lo(zz.x), y1 = O[dt][4 * g + 1] * rn * gn[1] * bf_hi(zz.x);
        const float y2 = O[dt][4 * g + 2] * rn * gn[2] * bf_lo(zz.y), y3 = O[dt][4 * g + 3] * rn * gn[3] * bf_hi(zz.y);
        u32x2 w; w.x = pk_bf16(y0, y1); w.y = pk_bf16(y2, y3);
        *(u32x2*)(mo + dv) = w;
      }
  }
}

constexpr int GL_QIN = 0, GL_KIN = 8192, GL_KST = 16384, GL_DEC = 24576, GL_CS = 24832, GL_XST = 26880, GL_OSQ = 43264, GL_PF = 44288;
constexpr int GP_VT = 0, GP_Q = 16384, GP_K = 24576, GP_LA = 32768, GP_SZ = 49152;
DI unsigned sw128(int row, int chunk) { return (unsigned)(row * 128 + ((chunk ^ ((row >> 1) & 7)) << 4)); }

DI void gla_item(const Params& p, const int bh, unsigned char* smem, const int t) {
  const int lane = t & 63, wid = t >> 6, r32 = lane & 31, hl = lane >> 5;
  const int vt = wid & 3, kt = wid >> 2, it = kt;
  const int b = bh >> 2, hd = bh & 3;
  const size_t tokb = (size_t)b * SEQ;
  const int d = lane, jg = wid, col = hd * 64 + d;
  f32x16 St;
#pragma unroll
  for (int r = 0; r < 16; ++r) St[r] = 0.f;
  const int L0 = wid * 128 + lane, L1 = L0 + 64, vr0 = L0 >> 3, vr1 = L1 >> 3;
  const bf16_t* vg0 = p.gvT + ((size_t)bh * 128 + vr0) * SEQ + (((L0 & 7) ^ ((vr0 >> 1) & 7)) << 3);
  const bf16_t* vg1 = p.gvT + ((size_t)bh * 128 + vr1) * SEQ + (((L1 & 7) ^ ((vr1 >> 1) & 7)) << 3);
  const int Lq = wid * 64 + lane;
  const bf16_t* qg = p.proj + (tokb + (Lq >> 3)) * NP + C_GQ + hd * 64 + (Lq & 7) * 8;
  const bf16_t* kg = p.proj + (tokb + (Lq >> 3)) * NP + C_GK + hd * 64 + (Lq & 7) * 8;
  const int La0 = wid * 128 + lane, La1 = La0 + 64;
  const float* lag0 = p.la + (tokb + (La0 >> 4)) * 256 + hd * 64 + (La0 & 15) * 4;
  const float* lag1 = p.la + (tokb + (La1 >> 4)) * 256 + hd * 64 + (La1 & 15) * 4;
#define GL_STAGE(bufo, ch_) do { \
    __builtin_amdgcn_global_load_lds((const unsigned*)(vg0 + (ch_) * 64), (unsigned*)(smem + (bufo) + GP_VT + wid * 2048), 16, 0, 0); \
    __builtin_amdgcn_global_load_lds((const unsigned*)(vg1 + (ch_) * 64), (unsigned*)(smem + (bufo) + GP_VT + wid * 2048 + 1024), 16, 0, 0); \
    __builtin_amdgcn_global_load_lds((const unsigned*)(qg + (size_t)(ch_) * 64 * NP), (unsigned*)(smem + (bufo) + GP_Q + wid * 1024), 16, 0, 0); \
    __builtin_amdgcn_global_load_lds((const unsigned*)(kg + (size_t)(ch_) * 64 * NP), (unsigned*)(smem + (bufo) + GP_K + wid * 1024), 16, 0, 0); \
    __builtin_amdgcn_global_load_lds((const unsigned*)(lag0 + (size_t)(ch_) * 64 * 256), (unsigned*)(smem + (bufo) + GP_LA + wid * 2048), 16, 0, 0); \
    __builtin_amdgcn_global_load_lds((const unsigned*)(lag1 + (size_t)(ch_) * 64 * 256), (unsigned*)(smem + (bufo) + GP_LA + wid * 2048 + 1024), 16, 0, 0); } while (0)
  const int krow = swap23(r32);
  const int qi = it * 32 + r32;
  float* cs = (float*)(smem + GL_CS); float* dec = (float*)(smem + GL_DEC); float* osq = (float*)(smem + GL_OSQ);
  const int v0 = hd * 128 + vt * 32 + 4 * hl;
  f32x4 gnv[4];
#pragma unroll
  for (int g = 0; g < 4; ++g) gnv[g] = *(const f32x4*)(p.gla_gain + v0 + 8 * g);
  __syncthreads();
  GL_STAGE(GL_PF, 0);
  asm volatile("s_waitcnt vmcnt(0)" ::: "memory");
  __syncthreads();
  for (int ch = 0; ch < SEQ / 64; ++ch) {
    const size_t tok0 = tokb + (size_t)ch * 64;
    unsigned char* pb = smem + GL_PF + (ch & 1) * GP_SZ;
    if (ch + 1 < SEQ / 64) GL_STAGE(GL_PF + ((ch + 1) & 1) * GP_SZ, ch + 1);
    const bf16_t* zp = p.proj + (tok0 + qi) * NP + C_GZ + v0;
    u32x2 zz[4];
#pragma unroll
    for (int g = 0; g < 4; ++g) zz[g] = *(const u32x2*)(zp + 8 * g);
    float la[8], qv[8], kv[8];
    {
      float run = 0.f;
#pragma unroll
      for (int e = 0; e < 8; ++e) {
        const int j = jg * 8 + e;
        run += *(const float*)(pb + GP_LA + j * 256 + d * 4); la[e] = run;
        qv[e] = bf2f(*(const bf16_t*)(pb + GP_Q + j * 128 + d * 2)); kv[e] = bf2f(*(const bf16_t*)(pb + GP_K + j * 128 + d * 2));
      }
      cs[jg * 64 + d] = run;
    }
    LBAR();
    {
      float pre = 0.f, tot = 0.f;
#pragma unroll
      for (int g = 0; g < 8; ++g) { const float c = cs[g * 64 + d]; tot += c; if (g < jg) pre += c; }
      const float etot = __builtin_amdgcn_exp2f(tot * 1.44269504f);
      float ks[8];
#pragma unroll
      for (int e = 0; e < 8; ++e) {
        const int j = jg * 8 + e; const float bc = pre + la[e];
        const float eb = __builtin_amdgcn_exp2f(bc * 1.44269504f), ib = __builtin_amdgcn_rcpf(eb);
        const float qin = qv[e] * 0.125f * eb, kin = kv[e] * ib;
        ks[e] = kin * etot;
        const unsigned off = sw128(j, d >> 3) + ((d & 7) << 1);
        *(bf16_t*)(smem + GL_QIN + off) = (bf16_t)(pk_bf16(qin, 0.f) & 0xffff);
        *(bf16_t*)(smem + GL_KIN + off) = (bf16_t)(pk_bf16(kin, 0.f) & 0xffff);
      }
      u32x4 w; w.x = pk_bf16(ks[0], ks[1]); w.y = pk_bf16(ks[2], ks[3]); w.z = pk_bf16(ks[4], ks[5]); w.w = pk_bf16(ks[6], ks[7]);
      *(u32x4*)(smem + GL_KST + sw128(d, jg)) = w;
      if (jg == 0) dec[d] = etot;
      *(bf16x8*)(smem + GL_XST + ((wid * 2 + 0) * 64 + lane) * 16) = pack8(St, 0);
      *(bf16x8*)(smem + GL_XST + ((wid * 2 + 1) * 64 + lane) * 16) = pack8(St, 1);
    }
    LBAR();
    f32x16 Oacc;
#pragma unroll
    for (int r = 0; r < 16; ++r) Oacc[r] = 0.f;
#pragma unroll
    for (int js = 0; js < 2; ++js) {
      if (js > it) continue;
      f32x16 S;
#pragma unroll
      for (int r = 0; r < 16; ++r) S[r] = 0.f;
#pragma unroll
      for (int sl = 0; sl < 4; ++sl) {
        const bf16x8 af = *(const bf16x8*)(smem + GL_KIN + sw128(js * 32 + krow, sl * 2 + hl));
        const bf16x8 bq = *(const bf16x8*)(smem + GL_QIN + sw128(qi, sl * 2 + hl));
        S = MFMA32(af, bq, S);
      }
      if (js == it) {
#pragma unroll
        for (int r = 0; r < 16; ++r) { const int kof = 16 * (r >> 3) + (r & 7) + 8 * hl; if (kof > r32) S[r] = 0.f; }
      }
      const bf16x8 pf0 = pack8(S, 0), pf1 = pack8(S, 1);
      const bf16x8 va = *(const bf16x8*)(pb + GP_VT + sw128(vt * 32 + r32, js * 4 + 0 + hl));
      const bf16x8 vb = *(const bf16x8*)(pb + GP_VT + sw128(vt * 32 + r32, js * 4 + 2 + hl));
      Oacc = MFMA32(va, pf0, Oacc); Oacc = MFMA32(vb, pf1, Oacc);
    }
#pragma unroll
    for (int kk = 0; kk < 2; ++kk)
#pragma unroll
      for (int s2 = 0; s2 < 2; ++s2) {
        const bf16x8 sf = *(const bf16x8*)(smem + GL_XST + (((kk * 4 + vt) * 2 + s2) * 64 + lane) * 16);
        const bf16x8 bq = *(const bf16x8*)(smem + GL_QIN + sw128(qi, kk * 4 + s2 * 2 + hl));
        Oacc = MFMA32(sf, bq, Oacc);
      }
    {
      const float* dp = dec + kt * 32 + 8 * hl;
      const f32x4 d0 = *(const f32x4*)(dp), d1 = *(const f32x4*)(dp + 4), d2 = *(const f32x4*)(dp + 16), d3 = *(const f32x4*)(dp + 20);
#pragma unroll
      for (int j = 0; j < 4; ++j) { St[j] *= d0[j]; St[4 + j] *= d1[j]; St[8 + j] *= d2[j]; St[12 + j] *= d3[j]; }
#pragma unroll
      for (int ks = 0; ks < 4; ++ks) {
        const bf16x8 af = *(const bf16x8*)(smem + GL_KST + sw128(kt * 32 + krow, ks * 2 + hl));
        const bf16x8 bv = *(const bf16x8*)(pb + GP_VT + sw128(vt * 32 + r32, ks * 2 + hl));
        St = MFMA32(af, bv, St);
      }
    }
    {
      float ss = 0.f;
#pragma unroll
      for (int r = 0; r < 16; ++r) ss += Oacc[r] * Oacc[r];
      ss += __shfl_xor(ss, 32);
      if (hl == 0) osq[vt * 64 + qi] = ss;
    }
    asm volatile("s_waitcnt vmcnt(0)" ::: "memory");
    LBAR();
    {
      const float tot = osq[qi] + osq[64 + qi] + osq[128 + qi] + osq[192 + qi];
      const float rn = rsqrtf(tot * (1.f / 128.f) + EPS);
      bf16_t* mo = p.mix + (tok0 + qi) * 1024 + v0;
#pragma unroll
      for (int g = 0; g < 4; ++g) {
        const f32x4 gn = gnv[g];
        const float y0 = Oacc[4 * g + 0] * rn * gn[0] * bf_lo(zz[g].x), y1 = Oacc[4 * g + 1] * rn * gn[1] * bf_hi(zz[g].x);
        const float y2 = Oacc[4 * g + 2] * rn * gn[2] * bf_lo(zz[g].y), y3 = Oacc[4 * g + 3] * rn * gn[3] * bf_hi(zz[g].y);
        u32x2 w; w.x = pk_bf16(y0, y1); w.y = pk_bf16(y2, y3);
        *(u32x2*)(mo + 8 * g) = w;
      }
    }
  }
#undef GL_STAGE
}

DI void mixer_phase(const Params& p, unsigned char* smem, const int t, const int cidx = 0, const int first = 0, const int limit = 100000) {
  const float lam = lam_value(p, t);
  constexpr int N_GLA = 64, N_ATT = 64 * 16;
  volatile int* sitem = (volatile int*)(smem + LDS_BYTES - 16);
  for (;;) {
    __syncthreads();
    if (t == 0) *sitem = first + (int)atomicAdd(p.ctr + cidx, 1u);
    __syncthreads();
    const int item = *sitem;
    if (item >= N_GLA + N_ATT || item >= limit) break;
#ifndef NO_GLA
    if (item < N_GLA) gla_item(p, item, smem, fresh_tid());
#endif
#ifndef NO_ATT
    if (item >= N_GLA) { const int a = item - N_GLA; attn_item(p, a & 63, 15 - (a >> 6), lam, smem, fresh_tid()); }
#endif
  }
}

DI void final_phase(const Params& p, const int t) {
  const size_t n4 = (size_t)NTOK * 1024 / 4;
  for (size_t i = (size_t)blockIdx.x * NTHREADS + t; i < n4; i += (size_t)gridDim.x * NTHREADS) {
    const size_t row = i >> 8; const int c4 = (int)(i & 255) * 4;
    const float r = rsqrtf(p.rowsq[row] * (1.f / 1024.f) + EPS);
    const f32x4 y = *(const f32x4*)(p.out + i * 4), gv = *(const f32x4*)(p.final_gain + c4);
    *(f32x4*)(p.out + i * 4) = y * r * gv;
  }
}

typedef const __attribute__((address_space(4))) Params* ParamsK;
DI Params fresh_params() {
#if defined(__HIP_DEVICE_COMPILE__)
  ParamsK kp = (ParamsK)__builtin_amdgcn_kernarg_segment_ptr(); asm volatile("" : "+s"(kp));
  Params r; __builtin_memcpy_inline(&r, kp, sizeof(Params)); return r;
#else
  return Params{};
#endif
}

__global__ void __launch_bounds__(NTHREADS, 2) fwd_kernel(Params p_) {
  extern __shared__ __attribute__((aligned(16))) unsigned char smem[];
  cg::grid_group grid = cg::this_grid();
  const int lo = p_.phase_lo, hi = p_.phase_hi;
  if (hi == 99) grid.sync();
  volatile LAS unsigned* st = (volatile LAS unsigned*)(smem + LDS_BYTES - 32);
  if (lo < hi) {
    if (threadIdx.x == 0) { st[0] = 0u; st[1] = 0u; (void)xb_add(&p_.bar[XB_XCNT(xb_xcc_id())], 1u); }
    __syncthreads();
  }
#define SEAM(a_) do { if (lo <= (a_) && (a_) + 1 <= hi) { const Params pb = fresh_params(); xcd_barrier(pb.bar, st); } } while (0)
#ifndef PHM
#define PHM 63
#endif
  if ((PHM & 1) && lo <= 0 && 0 <= hi) { const Params p = fresh_params(); phase0a(p, smem, fresh_tid()); }
  SEAM(0);
  if ((PHM & 2) && lo <= 1 && 1 <= hi) { const Params p = fresh_params(); phase0b(p, smem, fresh_tid()); }
  SEAM(1);
  if ((PHM & 4) && lo <= 2 && 2 <= hi) { const Params p = fresh_params(); gemm1_phase(p); }
  SEAM(2);
  if ((PHM & 8) && lo <= 3 && 3 <= hi) { const Params p = fresh_params(); mixer_phase(p, smem, fresh_tid()); }
  SEAM(3);
  if ((PHM & 16) && lo <= 4 && 4 <= hi) { const Params p = fresh_params(); gemm2_phase(p); }
}

extern "C" void kernel_launch(void* const* d_in, const int* in_sizes, int n_in, void* d_out, int out_size, void* d_ws, size_t ws_size, hipStream_t stream) {
  static int grid_blocks = 0;
  if (!grid_blocks) {
    hipFuncSetAttribute((const void*)fwd_kernel, hipFuncAttributeMaxDynamicSharedMemorySize, LDS_BYTES);
    int dev = 0, cus = 0, per_cu = 0;
    hipGetDevice(&dev);
    hipDeviceGetAttribute(&cus, hipDeviceAttributeMultiprocessorCount, dev);
    hipOccupancyMaxActiveBlocksPerMultiprocessor(&per_cu, fwd_kernel, NTHREADS, LDS_BYTES);
    if (per_cu < 1) per_cu = 1;
    grid_blocks = cus * per_cu;
  }
  Params p{};
  p.x = (const float*)d_in[0]; p.c = (const float*)d_in[1]; p.w_ada = (const float*)d_in[2]; p.b_ada = (const float*)d_in[3];
  p.norm_gain = (const float*)d_in[4]; p.w_in = (const float*)d_in[5]; p.w_up = (const float*)d_in[6]; p.b_gate = (const float*)d_in[7];
  p.gla_gain = (const float*)d_in[8]; p.lq1 = (const float*)d_in[9]; p.lk1 = (const float*)d_in[10]; p.lq2 = (const float*)d_in[11];
  p.lk2 = (const float*)d_in[12]; p.diff_gain = (const float*)d_in[13]; p.w_out = (const float*)d_in[14]; p.final_gain = (const float*)d_in[15];
  p.out = (float*)d_out;
  unsigned char* w = (unsigned char*)d_ws; size_t off = 0;
  auto take = [&](size_t bytes) { void* r = w + off; off += (bytes + 255) & ~(size_t)255; return r; };
  p.modpart = (float*)take((size_t)8 * 16 * 3072 * 4);
  p.mod = (float*)take((size_t)16 * 3072 * 4);
  p.rowsq = (float*)take((size_t)NTOK * 4);
  p.la = (float*)take((size_t)NTOK * 256 * 4);
  p.winT = (bf16_t*)take((size_t)NP * 1024 * 2);
  p.woutT = (bf16_t*)take((size_t)1024 * 1024 * 2);
  p.h = (bf16_t*)take((size_t)NTOK * 1024 * 2);
  p.proj = (bf16_t*)take((size_t)NTOK * NP * 2);
  p.mix = (bf16_t*)take((size_t)NTOK * 1024 * 2);
  p.gvT = (bf16_t*)take((size_t)NTOK * 512 * 2);
  p.dvT = (bf16_t*)take((size_t)NTOK * 512 * 2);
  p.bar = (unsigned*)take((size_t)XCD_BAR_WORDS * 4 + 1024);
  p.ctr = p.bar + XCD_BAR_WORDS;
  p.pcnt = p.ctr + 64;
#if 0
  hipMemsetAsync(p.bar, 0, (size_t)XCD_BAR_WORDS * 4 + 1024, stream);
  for (int ph = 0; ph < 5; ++ph) {
    p.phase_lo = ph; p.phase_hi = ph;
    hipLaunchKernelGGL(fwd_kernel, dim3(grid_blocks), dim3(NTHREADS), LDS_BYTES, stream, p);
  }
#else
  p.phase_lo = 0; p.phase_hi = 4;
  hipMemsetAsync(p.bar, 0, (size_t)XCD_BAR_WORDS * 4 + 1024, stream);
  void* args[] = {&p};
  hipError_t e = hipLaunchCooperativeKernel((void*)fwd_kernel, dim3(grid_blocks), dim3(NTHREADS), args, LDS_BYTES, stream);
  if (e != hipSuccess) fprintf(stderr, "cooperative launch failed: %s (grid %d)\n", hipGetErrorString(e), grid_blocks);
#endif
}
```

```cpp
#include <hip/hip_runtime.h>
#include <hip/hip_cooperative_groups.h>
#include <cstdio>
#include <cstdint>
namespace cg = cooperative_groups;

typedef unsigned short bf16_t;
typedef short bf16x8 __attribute__((ext_vector_type(8)));
typedef float f32x4 __attribute__((ext_vector_type(4)));
typedef float f32x2 __attribute__((ext_vector_type(2)));
typedef __bf16 bf16v2 __attribute__((ext_vector_type(2)));
typedef unsigned u32x4 __attribute__((ext_vector_type(4)));
typedef unsigned u32x2 __attribute__((ext_vector_type(2)));

#define DI __device__ __forceinline__

constexpr int D_MODEL = 1024, BATCH = 16, SEQ = 2048, NTOK = BATCH * SEQ;
constexpr int D_IN = 3600, NP = 3584;
constexpr int C_GQ = 0, C_GK = 256, C_GV = 512, C_GZ = 1024, C_DQ = 1536, C_DK = 2048, C_DV = 2560, C_DZ = 3072;
constexpr int NTHREADS = 512;
constexpr int LDS_BYTES = 147456;
constexpr float EPS = 1e-6f;

struct Params {
  const float *x, *c, *w_ada, *b_ada, *norm_gain, *w_in, *w_up, *b_gate, *gla_gain, *lq1, *lk1, *lq2, *lk2, *diff_gain, *w_out, *final_gain;
  float* out;
  float* modpart;
  float* mod;
  float* rowsq;
  float* la;
  bf16_t* winT;
  bf16_t* woutT;
  bf16_t* h;
  bf16_t* proj;
  bf16_t* mix;
  bf16_t* gvT;
  bf16_t* dvT;
  unsigned* ctr;
  unsigned* bar;
  unsigned* pcnt;
  int phase_lo, phase_hi;
};

DI unsigned pk_bf16(float a, float b) { f32x2 v = {a, b}; bf16v2 r = __builtin_convertvector(v, bf16v2); return __builtin_bit_cast(unsigned, r); }
DI float bf_lo(unsigned u) { return __uint_as_float(u << 16); }
DI float bf_hi(unsigned u) { return __uint_as_float(u & 0xffff0000u); }
DI float bf2f(bf16_t u) { return __uint_as_float(((unsigned)u) << 16); }
DI float wave_sum(float v) {
#pragma unroll
  for (int o = 32; o >= 1; o >>= 1) v += __shfl_xor(v, o);
  return v;
}
DI float wave_max(float v) {
#pragma unroll
  for (int o = 32; o >= 1; o >>= 1) v = fmaxf(v, __shfl_xor(v, o));
  return v;
}
DI float silu_f(float v) { return v * __builtin_amdgcn_rcpf(1.f + __builtin_amdgcn_exp2f(-1.44269504f * v)); }

#define XB_TMO      128
#define XB_XCNT(j)  (256  + 64 * (j))
#define XB_XSUB(j)  (1280 + 64 * (j))
#define XB_XGEN(j)  (2304 + 64 * (j))
#define XB_TOP      3328
#define XB_TOPGEN   3392
#define XCD_BAR_WORDS 3456
#define XB_SPIN_CAP (1u << 20)
#define LAS __attribute__((address_space(3)))
DI unsigned xb_ld(unsigned* p)              { return __hip_atomic_load(p, __ATOMIC_RELAXED, __HIP_MEMORY_SCOPE_AGENT); }
DI unsigned xb_add(unsigned* p, unsigned v) { return __hip_atomic_fetch_add(p, v, __ATOMIC_RELAXED, __HIP_MEMORY_SCOPE_AGENT); }
DI unsigned xb_xcc_id() { return (unsigned)__builtin_amdgcn_s_getreg((3 << 11) | 20) & 0xFu; }
#define XB_SPIN(cond, bar) do { unsigned _sp = 0; while (cond) { __builtin_amdgcn_s_sleep(1); \
    if ((++_sp & 255u) == 0u) { if (xb_ld(&(bar)[XB_TMO])) break; if (_sp > XB_SPIN_CAP) { atomicAdd(&(bar)[XB_TMO], 1u); break; } } } } while (0)
DI void xcd_barrier_complete(unsigned* bar, unsigned x, unsigned& nloc, unsigned& nx) {
  const unsigned G = gridDim.x;
  unsigned sum, cnt, mine, sp = 0u;
  for (;;) {
    sum = 0u; cnt = 0u; mine = 0u;
#pragma unroll
    for (unsigned j = 0; j < 16; ++j) { const unsigned c = xb_ld(&bar[XB_XCNT(j)]); sum += c; cnt += (c > 0u) ? 1u : 0u; mine = (j == x) ? c : mine; }
    if (sum == G) break;
    __builtin_amdgcn_s_sleep(1);
    if ((++sp & 255u) == 0u) { if (xb_ld(&bar[XB_TMO])) break; if (sp > XB_SPIN_CAP) { atomicAdd(&bar[XB_TMO], 1u); break; } }
  }
  nloc = mine > 0u ? mine : 1u; nx = cnt > 0u ? cnt : 1u;
}
DI void xcd_barrier(unsigned* bar, volatile LAS unsigned* st) {
  asm volatile("s_waitcnt vmcnt(0)" ::: "memory");
  __syncthreads();
  if (threadIdx.x == 0) {
    const unsigned x = xb_xcc_id();
    __builtin_amdgcn_s_waitcnt(0);
    unsigned nloc = st[0], nx = st[1];
    if (nloc == 0u) { xcd_barrier_complete(bar, x, nloc, nx); st[0] = nloc; st[1] = nx; }
    const unsigned old = xb_add(&bar[XB_XSUB(x)], 1u);
    const unsigned gen = old / nloc;
    if (old + 1u == (gen + 1u) * nloc) {
      __builtin_amdgcn_fence(__ATOMIC_RELEASE, "agent");
      asm volatile("s_waitcnt vmcnt(0)" ::: "memory");
      const unsigned og = xb_add(&bar[XB_TOP], 1u);
      const unsigned tg = og / nx;
      if (og + 1u == (tg + 1u) * nx) xb_add(&bar[XB_TOPGEN], 1u);
      else XB_SPIN(xb_ld(&bar[XB_TOPGEN]) == tg, bar);
      __builtin_amdgcn_fence(__ATOMIC_ACQUIRE, "agent");
      xb_add(&bar[XB_XGEN(x)], 1u);
      asm volatile("s_waitcnt vmcnt(0)" ::: "memory");
    } else {
      XB_SPIN(xb_ld(&bar[XB_XGEN(x)]) == gen, bar);
      __builtin_amdgcn_fence(__ATOMIC_ACQUIRE, "agent");
      asm volatile("s_waitcnt vmcnt(0)" ::: "memory");
    }
  }
  __syncthreads();
}

DI int fresh_tid() { int t = threadIdx.x; asm volatile("" : "+v"(t)); return t; }

DI int perm32(int r) { return 8 * ((r & 15) >> 2) + 4 * (r >> 4) + (r & 3); }
DI int inv32(int a) { return ((a >> 2) & 1) * 16 + (a >> 3) * 4 + (a & 3); }

DI void phase0a(const Params& p, unsigned char* smem, const int t) {
  for (int i = blockIdx.x * NTHREADS + t; i < NTOK; i += gridDim.x * NTHREADS) p.rowsq[i] = 0.f;
  constexpr int N_MOD = 192, N_WIN = 16 * 56, N_WOUT = 16 * 16;
  for (int item = blockIdx.x; item < N_MOD + N_WIN + N_WOUT; item += gridDim.x) {
    __syncthreads();
    if (item < N_MOD) {
      const int nc = item % 24, ks = item / 24, n0 = nc * 128, k0 = ks * 128;
      float* sc = (float*)smem;
      float* red = sc + 16 * 128;
      for (int e = t; e < 2048; e += NTHREADS) { const int b = e >> 7, kk = e & 127; sc[e] = silu_f(p.c[b * 1024 + k0 + kk]); }
      __syncthreads();
      const int nl = t & 127, sub = t >> 7;
      float acc[16];
#pragma unroll
      for (int b = 0; b < 16; ++b) acc[b] = 0.f;
      for (int kk = sub * 32; kk < sub * 32 + 32; ++kk) {
        const float w = p.w_ada[(size_t)(k0 + kk) * 3072 + n0 + nl];
#pragma unroll
        for (int b = 0; b < 16; ++b) acc[b] += sc[b * 128 + kk] * w;
      }
#pragma unroll
      for (int b = 0; b < 16; ++b) red[(sub * 16 + b) * 128 + nl] = acc[b];
      __syncthreads();
      for (int e = t; e < 2048; e += NTHREADS) {
        const int b = e >> 7, n = e & 127;
        p.modpart[((size_t)ks * 16 + b) * 3072 + n0 + n] = red[(0 * 16 + b) * 128 + n] + red[(1 * 16 + b) * 128 + n] + red[(2 * 16 + b) * 128 + n] + red[(3 * 16 + b) * 128 + n];
      }
    } else {
      const float* src; bf16_t* dst; int ld, k0, n0, ncol;
      if (item < N_MOD + N_WIN) { const int it = item - N_MOD; k0 = (it % 16) * 64; n0 = (it / 16) * 64; src = p.w_in; ld = D_IN; dst = p.winT; ncol = n0 < C_DQ ? n0 : n0 + 16; }
      else { const int it = item - N_MOD - N_WIN; k0 = (it % 16) * 64; n0 = (it / 16) * 64; src = p.w_out; ld = 1024; dst = p.woutT; ncol = n0; }
      float* tile = (float*)smem;
#pragma unroll
      for (int e = 0; e < 8; ++e) { const int idx = e * NTHREADS + t, r = idx >> 6, cc = idx & 63; tile[r * 65 + cc] = src[(size_t)(k0 + r) * ld + ncol + cc]; }
      __syncthreads();
      const int n = t >> 3, ksg = (t & 7) * 8;
      const int ns = (src == p.w_in) ? ((n & ~31) | perm32(n & 31)) : n;
      u32x4 w;
      w.x = pk_bf16(tile[(ksg + 0) * 65 + ns], tile[(ksg + 1) * 65 + ns]);
      w.y = pk_bf16(tile[(ksg + 2) * 65 + ns], tile[(ksg + 3) * 65 + ns]);
      w.z = pk_bf16(tile[(ksg + 4) * 65 + ns], tile[(ksg + 5) * 65 + ns]);
      w.w = pk_bf16(tile[(ksg + 6) * 65 + ns], tile[(ksg + 7) * 65 + ns]);
      *(u32x4*)(dst + (size_t)(n0 + n) * 1024 + k0 + ksg) = w;
    }
  }
}

DI void phase0b(const Params& p, unsigned char* smem, const int t) {
  const int lane = t & 63, wid = t >> 6;
  for (int i = blockIdx.x * NTHREADS + t; i < 16 * 3072; i += gridDim.x * NTHREADS) {
    float s = p.b_ada[i % 3072];
#pragma unroll
    for (int ks = 0; ks < 8; ++ks) s += p.modpart[(size_t)ks * 16 * 3072 + i];
    p.mod[i] = s;
  }
  float* g = (float*)smem;
  float* sh = g + 1024;
  float* wg = sh + 1024;
  f32x4 wup[16];
#pragma unroll
  for (int r = 0; r < 16; ++r) wup[r] = *(const f32x4*)(p.w_up + r * 256 + lane * 4);
  const f32x4 bgv = *(const f32x4*)(p.b_gate + lane * 4);
  for (int item = blockIdx.x; item < NTOK / 128; item += gridDim.x) {
    const int b = item / 16, row0 = item * 128;
    __syncthreads();
    for (int k = t; k < 1024; k += NTHREADS) {
      float s_sh = p.b_ada[k], s_sc = p.b_ada[1024 + k];
#pragma unroll
      for (int ks = 0; ks < 8; ++ks) { s_sh += p.modpart[((size_t)ks * 16 + b) * 3072 + k]; s_sc += p.modpart[((size_t)ks * 16 + b) * 3072 + 1024 + k]; }
      g[k] = p.norm_gain[k] * (1.f + s_sc); sh[k] = s_sh;
    }
    for (int e = t; e < 4096; e += NTHREADS) {
      const int r = e & 15, L = (e >> 4) & 63, i = e >> 10, k = i * 256 + 4 * L;
      const float* wp = p.w_in + (size_t)k * D_IN + 1536 + r;
      u32x2 w; w.x = pk_bf16(wp[0], wp[D_IN]); w.y = pk_bf16(wp[2 * D_IN], wp[3 * D_IN]);
      *(u32x2*)((unsigned char*)wg + (i * 64 + L) * 128 + (((r >> 1) ^ ((L >> 1) & 7)) << 4) + (r & 1) * 8) = w;
    }
    __syncthreads();
    f32x4 xn[4];
#pragma unroll
    for (int i = 0; i < 4; ++i) xn[i] = *(const f32x4*)(p.x + (size_t)(row0 + wid) * 1024 + i * 256 + lane * 4);
    for (int rr = wid; rr < 128; rr += 8) {
      const size_t row = row0 + rr;
      const size_t hrow = (row & ~(size_t)31) | (size_t)inv32((int)(row & 31));
      f32x4 xv[4];
#pragma unroll
      for (int i = 0; i < 4; ++i) xv[i] = xn[i];
      if (rr + 8 < 128) {
#pragma unroll
        for (int i = 0; i < 4; ++i) xn[i] = *(const f32x4*)(p.x + (row + 8) * 1024 + i * 256 + lane * 4);
      }
      float ss = 0.f;
#pragma unroll
      for (int i = 0; i < 4; ++i) ss += xv[i][0] * xv[i][0] + xv[i][1] * xv[i][1] + xv[i][2] * xv[i][2] + xv[i][3] * xv[i][3];
      ss = wave_sum(ss);
      const float rstd = rsqrtf(ss * (1.f / 1024.f) + EPS);
      float pr[16];
#pragma unroll
      for (int r = 0; r < 16; ++r) pr[r] = 0.f;
#pragma unroll
      for (int i = 0; i < 4; ++i) {
        const int k = i * 256 + lane * 4;
        const f32x4 gv = *(const f32x4*)(g + k), sv = *(const f32x4*)(sh + k);
        const f32x4 hv = xv[i] * rstd * gv + sv;
        u32x2 w; w.x = pk_bf16(hv[0], hv[1]); w.y = pk_bf16(hv[2], hv[3]);
        *(u32x2*)(p.h + hrow * 1024 + k) = w;
        const unsigned char* wrow = (const unsigned char*)wg + (i * 64 + lane) * 128;
#pragma unroll
        for (int c = 0; c < 8; ++c) {
          const u32x4 wv = *(const u32x4*)(wrow + ((c ^ ((lane >> 1) & 7)) << 4));
          asm volatile("v_dot2c_f32_bf16 %0, %1, %2" : "+v"(pr[2 * c]) : "v"(w.x), "v"(wv.x));
          asm volatile("v_dot2c_f32_bf16 %0, %1, %2" : "+v"(pr[2 * c]) : "v"(w.y), "v"(wv.y));
          asm volatile("v_dot2c_f32_bf16 %0, %1, %2" : "+v"(pr[2 * c + 1]) : "v"(w.x), "v"(wv.z));
          asm volatile("v_dot2c_f32_bf16 %0, %1, %2" : "+v"(pr[2 * c + 1]) : "v"(w.y), "v"(wv.w));
        }
        __builtin_amdgcn_sched_barrier(0);
      }
      float a8[8], a4[4], a2[2], a1;
      { const bool hi = lane & 1;
#pragma unroll
        for (int i = 0; i < 8; ++i) { const float keep = hi ? pr[i + 8] : pr[i], send = hi ? pr[i] : pr[i + 8]; a8[i] = keep + __shfl_xor(send, 1); } }
      { const bool hi = lane & 2;
#pragma unroll
        for (int i = 0; i < 4; ++i) { const float keep = hi ? a8[i + 4] : a8[i], send = hi ? a8[i] : a8[i + 4]; a4[i] = keep + __shfl_xor(send, 2); } }
      { const bool hi = lane & 4;
#pragma unroll
        for (int i = 0; i < 2; ++i) { const float keep = hi ? a4[i + 2] : a4[i], send = hi ? a4[i] : a4[i + 2]; a2[i] = keep + __shfl_xor(send, 4); } }
      { const bool hi = lane & 8; const float keep = hi ? a2[1] : a2[0], send = hi ? a2[0] : a2[1]; a1 = keep + __shfl_xor(send, 8); }
      a1 += __shfl_xor(a1, 16); a1 += __shfl_xor(a1, 32);
      float* grs = (float*)(smem + 73728) + wid * 16;
      if (lane < 16) grs[8 * (lane & 1) + 4 * ((lane >> 1) & 1) + 2 * ((lane >> 2) & 1) + ((lane >> 3) & 1)] = a1;
      const f32x4 g0 = *(const f32x4*)(grs), g1 = *(const f32x4*)(grs + 4), g2 = *(const f32x4*)(grs + 8), g3 = *(const f32x4*)(grs + 12);
      f32x4 lg = bgv;
#pragma unroll
      for (int j = 0; j < 4; ++j) {
        lg += g0[j] * wup[j] + g1[j] * wup[4 + j] + g2[j] * wup[8 + j] + g3[j] * wup[12 + j];
      }
      f32x4 lav;
#pragma unroll
      for (int j = 0; j < 4; ++j) lav[j] = (fminf(lg[j], 0.f) - __logf(1.f + __expf(-fabsf(lg[j])))) * (1.f / 16.f);
      *(f32x4*)(p.la + row * 256 + lane * 4) = lav;
    }
  }
}

constexpr int BM = 256, BK = 64, HALF = 128, NXCD = 8, WGM = 8, HT = HALF * BK;
DI int lds_byte(int r, int c) { int st = (r >> 4) * 2 + (c >> 5), rr = r & 15, cc = c & 31, ob = rr * 64 + cc * 2; return st * 1024 + (ob ^ (((ob >> 9) & 1) << 5)); }
DI void stage_rc(int b, int& R, int& C) { int st = b / 1024, sb = b % 1024, swz = sb ^ (((sb >> 9) & 1) << 5); R = (st >> 1) * 16 + swz / 64; C = (st & 1) * 32 + (swz % 64) / 2; }

template <class Epi>
DI void gemm_tile(const bf16_t* __restrict__ A, const bf16_t* __restrict__ Bt, const int K, const int brow, const int bcol, const Epi& epi) {
  extern __shared__ __attribute__((aligned(16))) unsigned char smem[];
  bf16_t* shm = (bf16_t*)smem;
#define SA(b, h) (shm + ((b) * 2 + (h)) * HT)
#define SB(b, h) (shm + (4 + (b) * 2 + (h)) * HT)
#define STAGE(P, BASE, br, kt) do { const bf16_t* _gb = (BASE) + ((long)(br) * K + (long)(kt) * BK); \
    __builtin_amdgcn_global_load_lds((const unsigned*)(_gb + toff0), (unsigned*)((char*)(P) + tb16), 16, 0, 0); \
    __builtin_amdgcn_global_load_lds((const unsigned*)(_gb + toff1), (unsigned*)((char*)(P) + tb16 + 8192), 16, 0, 0); } while (0)
#define LDA(dst, b, h) for (int m = 0; m < 4; ++m) for (int k = 0; k < 2; ++k) \
    dst[m][k] = *reinterpret_cast<const bf16x8*>(smem + a_base_ + (((b) * 2 + (h)) * 16384 + m * 2048 + k * 1024))
#define LDB(dst, b, h) for (int n = 0; n < 2; ++n) for (int k = 0; k < 2; ++k) \
    dst[n][k] = *reinterpret_cast<const bf16x8*>(smem + b_base_ + (((b) * 2 + (h)) * 16384 + n * 2048 + k * 1024))
#define MMA(ai, bj, At, Bt_) do { __builtin_amdgcn_s_setprio(1); \
    for (int m = 0; m < 4; ++m) for (int n = 0; n < 2; ++n) for (int k = 0; k < 2; ++k) \
      acc[ai][bj][m][n] = __builtin_amdgcn_mfma_f32_16x16x32_bf16(Bt_[n][k], At[m][k], acc[ai][bj][m][n], 0, 0, 0); \
    __builtin_amdgcn_s_setprio(0); } while (0)
#define WAIT_V(n) asm volatile("s_waitcnt vmcnt(" #n ")" ::: "memory")
#define WAIT_L(n) asm volatile("s_waitcnt lgkmcnt(" #n ")" ::: "memory")
#define BAR __builtin_amdgcn_s_barrier()
#define SCHED __builtin_amdgcn_sched_barrier(0)
  const int tid = fresh_tid();
  const int wid = tid >> 6, lane = tid & 63, wr = wid >> 2, wc = wid & 3, fr = lane & 15, fq = lane >> 4;
  const int tb16 = tid * 16;
  const unsigned a_base = (unsigned)lds_byte(wr * 64 + fr, fq * 8), b_base = 65536u + (unsigned)lds_byte(wc * 32 + fr, fq * 8);
  unsigned a_base_ = a_base, b_base_ = b_base; asm volatile("" : "+v"(a_base_), "+v"(b_base_));
  unsigned toff0, toff1;
  { int r0, c0, r1, c1; stage_rc(tb16, r0, c0); stage_rc(tb16 + 8192, r1, c1); toff0 = (unsigned)(r0 * K + c0); toff1 = (unsigned)(r1 * K + c1); }
  f32x4 acc[2][2][4][2] = {};
  bf16x8 At[4][2], B0[2][2], B1[2][2];
  const int nt = K / BK;
  STAGE(SB(0, 0), Bt, bcol, 0); STAGE(SA(0, 0), A, brow, 0);
  STAGE(SB(0, 1), Bt, bcol + HALF, 0); STAGE(SA(0, 1), A, brow + HALF, 0);
  if (wr == 1) BAR;
  WAIT_V(4); BAR;
  STAGE(SB(1, 0), Bt, bcol, 1); STAGE(SA(1, 0), A, brow, 1); STAGE(SB(1, 1), Bt, bcol + HALF, 1);
  WAIT_V(6); BAR;
  for (int t = 0; t < nt - 2; t += 2) {
    LDB(B0, 0, 0); SCHED; LDA(At, 0, 0); STAGE(SA(1, 1), A, brow + HALF, t + 1);
    WAIT_L(8); BAR; WAIT_L(0); MMA(0, 0, At, B0); BAR; SCHED;
    LDB(B1, 0, 1); STAGE(SB(0, 0), Bt, bcol, t + 2);
    BAR; WAIT_L(0); MMA(0, 1, At, B1); BAR;
    LDA(At, 0, 1); STAGE(SA(0, 0), A, brow, t + 2);
    BAR; WAIT_L(0); MMA(1, 0, At, B0); BAR; SCHED;
    STAGE(SB(0, 1), Bt, bcol + HALF, t + 2);
    WAIT_V(6); BAR; MMA(1, 1, At, B1); BAR;
    LDB(B0, 1, 0); SCHED; LDA(At, 1, 0); STAGE(SA(0, 1), A, brow + HALF, t + 2);
    WAIT_L(8); BAR; WAIT_L(0); MMA(0, 0, At, B0); BAR; SCHED;
    LDB(B1, 1, 1); STAGE(SB(1, 0), Bt, bcol, t + 3);
    BAR; WAIT_L(0); MMA(0, 1, At, B1); BAR;
    LDA(At, 1, 1); STAGE(SA(1, 0), A, brow, t + 3);
    BAR; WAIT_L(0); MMA(1, 0, At, B0); BAR; SCHED;
    STAGE(SB(1, 1), Bt, bcol + HALF, t + 3);
    WAIT_V(6); BAR; MMA(1, 1, At, B1); BAR;
  }
  { LDB(B0, 0, 0); LDA(At, 0, 0); STAGE(SA(1, 1), A, brow + HALF, nt - 1);
    BAR; WAIT_L(0); MMA(0, 0, At, B0); BAR;
    LDB(B1, 0, 1); BAR; WAIT_L(0); MMA(0, 1, At, B1); BAR;
    LDA(At, 0, 1); WAIT_V(4); BAR; WAIT_L(0); MMA(1, 0, At, B0); MMA(1, 1, At, B1); BAR; }
  { LDB(B0, 1, 0); LDA(At, 1, 0); WAIT_V(2); BAR; WAIT_L(0); MMA(0, 0, At, B0); BAR;
    LDB(B1, 1, 1); WAIT_V(0); BAR; WAIT_L(0); MMA(0, 1, At, B1); BAR;
    LDA(At, 1, 1); BAR; WAIT_L(0); MMA(1, 0, At, B0); MMA(1, 1, At, B1); BAR; }
  if (wr == 0) BAR;
  { int tid2 = threadIdx.x; asm volatile("" : "+v"(tid2));
    const int wid2 = tid2 >> 6, lane2 = tid2 & 63;
    epi(acc, brow, bcol, (wid2 >> 2) * 64, lane2 & 15, (wid2 & 3) * 32 + (lane2 >> 4) * 8, lane2); }
#undef SA
#undef SB
#undef STAGE
#undef LDA
#undef LDB
#undef MMA
}

DI bool tile_order(int i, int G, int c, int nM, int nN, int& pm, int& pn) {
  const int nwg = nM * nN; const long L = (long)i * G + c; if (L >= nwg) return false;
  int wgid = (int)L; { const int q = nwg / NXCD, r = nwg % NXCD, xcd = wgid % NXCD, off = wgid / NXCD; wgid = (xcd < r ? xcd * (q + 1) : r * (q + 1) + (xcd - r) * q) + off; }
  const int nig = WGM * nN, gid = wgid / nig, fm = gid * WGM, gsz = (nM - fm) < WGM ? (nM - fm) : WGM;
  pm = fm + ((wgid % nig) % gsz); pn = (wgid % nig) / gsz; return true;
}

struct EpiProj {
  bf16_t* O; bf16_t* gvT; bf16_t* dvT; int vmode;
  DI void operator()(f32x4 (&acc)[2][2][4][2], int brow, int bcol, int rw, int fr, int cw, int lane) const {
    const int rperm = 8 * (fr >> 2) + (fr & 3);
    if (vmode == 0) {
      const bool sil = (bcol >= C_GZ && bcol < C_DQ) || (bcol >= C_DZ);
#pragma unroll
      for (int ai = 0; ai < 2; ++ai)
#pragma unroll
        for (int m = 0; m < 4; ++m) {
          const int row = brow + ai * HALF + rw + (m >> 1) * 32 + 4 * (m & 1) + rperm;
          bf16_t* rp = O + (size_t)row * NP + bcol + cw;
#pragma unroll
          for (int bj = 0; bj < 2; ++bj) {
            f32x4 v0 = acc[ai][bj][m][0], v1 = acc[ai][bj][m][1];
            if (sil) {
#pragma unroll
              for (int j = 0; j < 4; ++j) { v0[j] = silu_f(v0[j]); v1[j] = silu_f(v1[j]); }
            }
            u32x4 w; w.x = pk_bf16(v0[0], v0[1]); w.y = pk_bf16(v0[2], v0[3]); w.z = pk_bf16(v1[0], v1[1]); w.w = pk_bf16(v1[2], v1[3]);
            *(u32x4*)(rp + bj * HALF) = w;
          }
        }
    } else {
      bf16_t* T = (vmode == 1) ? gvT : dvT;
      const int vbase = brow - ((vmode == 1) ? C_GV : C_DV);
      const int b = bcol / SEQ, s0 = bcol % SEQ + cw;
#pragma unroll
      for (int ai = 0; ai < 2; ++ai)
#pragma unroll
        for (int m = 0; m < 4; ++m) {
          const int v = vbase + ai * HALF + rw + (m >> 1) * 32 + 4 * (m & 1) + rperm;
          bf16_t* rp = T + ((size_t)b * 512 + v) * SEQ + s0;
#pragma unroll
          for (int bj = 0; bj < 2; ++bj) {
            const f32x4 v0 = acc[ai][bj][m][0], v1 = acc[ai][bj][m][1];
            u32x4 w; w.x = pk_bf16(v0[0], v0[1]); w.y = pk_bf16(v0[2], v0[3]); w.z = pk_bf16(v1[0], v1[1]); w.w = pk_bf16(v1[2], v1[3]);
            *(u32x4*)(rp + bj * HALF) = w;
          }
        }
    }
  }
};
struct EpiOut {
  const float* x; const float* mod; const float* fgain; float* out; float* rowsq; unsigned* pcnt;
  DI void operator()(f32x4 (&acc)[2][2][4][2], int brow, int bcol, int rw, int fr, int cwp, int lane) const {
    extern __shared__ __attribute__((aligned(16))) unsigned char smem[];
    constexpr int TS = 1040;
    const int b = brow / SEQ, wid = threadIdx.x >> 6;
    const int cw = (cwp & ~31) + ((cwp & 31) >> 1);
    f32x4 gt[2][2];
#pragma unroll
    for (int bj = 0; bj < 2; ++bj)
#pragma unroll
      for (int n = 0; n < 2; ++n) gt[bj][n] = *(const f32x4*)(mod + (size_t)b * 3072 + 2048 + bcol + cw + bj * HALF + n * 16);
    f32x4 Y[2][16];
    float myss[2] = {0.f, 0.f};
    __syncthreads();
#pragma unroll
    for (int ai = 0; ai < 2; ++ai) {
      const float* xb = x + (size_t)(brow + ai * HALF + wid * 16) * 1024 + bcol + lane * 4;
#pragma unroll
      for (int i = 0; i < 16; ++i) Y[ai][i] = *(const f32x4*)(xb + (size_t)i * 1024);
#pragma unroll
      for (int m = 0; m < 4; ++m)
#pragma unroll
        for (int bj = 0; bj < 2; ++bj)
#pragma unroll
          for (int n = 0; n < 2; ++n)
            *(f32x4*)(smem + (rw + m * 16 + fr) * TS + (bj * HALF + cw + n * 16) * 4) = gt[bj][n] * acc[ai][bj][m][n];
      __syncthreads();
#pragma unroll
      for (int i = 0; i < 16; ++i) {
        const f32x4 v = *(const f32x4*)(smem + (wid * 16 + i) * TS + lane * 16);
        const f32x4 y = Y[ai][i] + v; Y[ai][i] = y;
        const float ss = wave_sum(y[0] * y[0] + y[1] * y[1] + y[2] * y[2] + y[3] * y[3]);
        if (lane == i) myss[ai] = ss;
      }
      __syncthreads();
    }
    if (lane < 16) {
      (void)__hip_atomic_fetch_add(rowsq + (size_t)(brow + wid * 16 + lane), myss[0], __ATOMIC_RELAXED, __HIP_MEMORY_SCOPE_AGENT);
      (void)__hip_atomic_fetch_add(rowsq + (size_t)(brow + HALF + wid * 16 + lane), myss[1], __ATOMIC_RELAXED, __HIP_MEMORY_SCOPE_AGENT);
    }
    asm volatile("s_waitcnt vmcnt(0)" ::: "memory");
    __syncthreads();
    if (threadIdx.x == 0) {
      unsigned* c = pcnt + (brow >> 8);
      (void)__hip_atomic_fetch_add(c, 1u, __ATOMIC_RELAXED, __HIP_MEMORY_SCOPE_AGENT);
      unsigned sp = 0;
      while (__hip_atomic_load(c, __ATOMIC_RELAXED, __HIP_MEMORY_SCOPE_AGENT) < 4u) { __builtin_amdgcn_s_sleep(1); if (++sp > (1u << 22)) break; }
    }
    __syncthreads();
    float rn[2] = {0.f, 0.f};
    if (lane < 16) {
      rn[0] = rsqrtf(__hip_atomic_load(rowsq + (size_t)(brow + wid * 16 + lane), __ATOMIC_RELAXED, __HIP_MEMORY_SCOPE_AGENT) * (1.f / 1024.f) + EPS);
      rn[1] = rsqrtf(__hip_atomic_load(rowsq + (size_t)(brow + HALF + wid * 16 + lane), __ATOMIC_RELAXED, __HIP_MEMORY_SCOPE_AGENT) * (1.f / 1024.f) + EPS);
    }
    const f32x4 fg = *(const f32x4*)(fgain + bcol + lane * 4);
#pragma unroll
    for (int ai = 0; ai < 2; ++ai) {
      float* ob = out + (size_t)(brow + ai * HALF + wid * 16) * 1024 + bcol + lane * 4;
#pragma unroll
      for (int i = 0; i < 16; ++i) __builtin_nontemporal_store(Y[ai][i] * __shfl(rn[ai], i) * fg, (f32x4*)(ob + (size_t)i * 1024));
    }
  }
};

DI void gemm1_phase(const Params& p) {
  for (int i = 0;; ++i) {
    int pm, pn; if (!tile_order(i, gridDim.x, blockIdx.x, NTOK / BM, NP / BM, pm, pn)) break;
    const int vmode = (pn == 2 || pn == 3) ? 1 : ((pn == 10 || pn == 11) ? 2 : 0);
    const bf16_t* A = vmode ? p.winT : p.h; const bf16_t* Bt = vmode ? p.h : p.winT;
    const int brow = vmode ? pn * BM : pm * BM, bcol = vmode ? pm * BM : pn * BM;
    gemm_tile(A, Bt, 1024, brow, bcol, EpiProj{p.proj, p.gvT, p.dvT, vmode});
  }
}
DI void gemm2_phase(const Params& p) {
  for (int i = 0;; ++i) {
    int pm, pn; if (!tile_order(i, gridDim.x, blockIdx.x, NTOK / BM, 1024 / BM, pm, pn)) break;
    gemm_tile(p.mix, p.woutT, 1024, pm * BM, pn * BM, EpiOut{p.x, p.mod, p.final_gain, p.out, p.rowsq, p.pcnt});
  }
}

DI float lam_value(const Params& p, const int t) {
  const int i = t & 63;
  const float s1 = wave_sum(p.lq1[i] * p.lk1[i]), s2 = wave_sum(p.lq2[i] * p.lk2[i]);
  return __expf(s1) - __expf(s2) + 0.2f;
}

#define LBAR() do { asm volatile("s_waitcnt lgkmcnt(0)" ::: "memory"); __builtin_amdgcn_s_barrier(); asm volatile("" ::: "memory"); } while (0)

typedef float f32x16 __attribute__((ext_vector_type(16)));
#define MFMA32(a, b, c) __builtin_amdgcn_mfma_f32_32x32x16_bf16((a), (b), (c), 0, 0, 0)
constexpr int AT_KB = 16384, AT_VB = 16384, AT_BUF = AT_KB + AT_VB;

DI bf16x8 pack8(const f32x16& x, int s) {
  u32x4 p; p.x = pk_bf16(x[8 * s], x[8 * s + 1]); p.y = pk_bf16(x[8 * s + 2], x[8 * s + 3]); p.z = pk_bf16(x[8 * s + 4], x[8 * s + 5]); p.w = pk_bf16(x[8 * s + 6], x[8 * s + 7]);
  return __builtin_bit_cast(bf16x8, p);
}
DI int swap23(int x) { return (x & ~12) | ((x & 4) << 1) | ((x & 8) >> 1); }

constexpr int AT_K0 = 0, AT_V0 = 49152;
DI void attn_item(const Params& p, const int bh, const int qb, const float lam, unsigned char* smem, const int t) {
  const int lane = t & 63, wid = t >> 6, r32 = lane & 31, hl = lane >> 5;
  const int qg = wid & 3, mp = wid >> 2;
  const int b = bh >> 2, hd = bh & 3;
  const size_t tokb = (size_t)b * SEQ;
  const int q0 = qb * 128 + qg * 32, iq = q0 + r32;
  const float slope2 = exp2f(-2.f * (hd + 1)) * 1.44269504f;
  const f32x2 c1v = {0.125f * 1.44269504f, 0.125f * 1.44269504f};
  bf16x8 qf[4];
  {
    const bf16_t* qp = p.proj + (tokb + iq) * NP + C_DQ + hd * 128 + mp * 64 + hl * 8;
#pragma unroll
    for (int sl = 0; sl < 4; ++sl) qf[sl] = *(const bf16x8*)(qp + sl * 16);
  }
  f32x2 kb[8];
#pragma unroll
  for (int i = 0; i < 8; ++i) { const int kof = 16 * ((2 * i) >> 3) + ((2 * i) & 7) + 8 * hl; kb[i] = (f32x2){slope2 * (float)kof, slope2 * (float)(kof + 1)}; }
  f32x16 O[4];
#pragma unroll
  for (int dt = 0; dt < 4; ++dt)
#pragma unroll
    for (int r = 0; r < 16; ++r) O[dt][r] = 0.f;
  float mrun = 0.f, lrun = 0.f;
  const int L0 = wid * 128 + lane, L1 = L0 + 64;
  const int kr0 = L0 >> 4, kr1 = L1 >> 4;
  const bf16_t* kg0 = p.proj + (tokb + kr0) * NP + C_DK + hd * 128 + (((L0 & 15) ^ (kr0 & 15)) << 3);
  const bf16_t* kg1 = p.proj + (tokb + kr1) * NP + C_DK + hd * 128 + (((L1 & 15) ^ (kr1 & 15)) << 3);
  const int vr0 = L0 >> 3, vr1 = L1 >> 3;
  const bf16_t* vg0 = p.dvT + ((size_t)bh * 128 + vr0) * SEQ + (((L0 & 7) ^ ((vr0 >> 1) & 7)) << 3);
  const bf16_t* vg1 = p.dvT + ((size_t)bh * 128 + vr1) * SEQ + (((L1 & 7) ^ ((vr1 >> 1) & 7)) << 3);
  const unsigned wslot = wid * 2048;
#define AT_STAGE(kbo, vbo, jt_) do { \
    __builtin_amdgcn_global_load_lds((const unsigned*)(kg0 + (size_t)(jt_) * 64 * NP), (unsigned*)(smem + (kbo) + wslot), 16, 0, 0); \
    __builtin_amdgcn_global_load_lds((const unsigned*)(kg1 + (size_t)(jt_) * 64 * NP), (unsigned*)(smem + (kbo) + wslot + 1024), 16, 0, 0); \
    __builtin_amdgcn_global_load_lds((const unsigned*)(vg0 + (jt_) * 64), (unsigned*)(smem + (vbo) + wslot), 16, 0, 0); \
    __builtin_amdgcn_global_load_lds((const unsigned*)(vg1 + (jt_) * 64), (unsigned*)(smem + (vbo) + wslot + 1024), 16, 0, 0); } while (0)
  const int krow = swap23(r32);
  const unsigned kread = (krow * 256) | ((((krow & 15) ^ hl) << 4) ^ (mp << 7));
  const unsigned vread = r32 * 128 + ((hl ^ ((r32 >> 1) & 7)) << 4);
  const int nt = 2 * qb + 2, wnt = 2 * qb + (qg >> 1) + 1;
#define AT_QK(kbuf_) do { \
    bf16x8 kq0[4], kq1[4]; \
    _Pragma("unroll") for (int sl = 0; sl < 4; ++sl) { \
      kq0[sl] = *(const bf16x8*)((kbuf_) + (kread ^ (unsigned)((sl * 2) << 4))); \
      kq1[sl] = *(const bf16x8*)((kbuf_) + 8192 + (kread ^ (unsigned)((sl * 2) << 4))); } \
    _Pragma("unroll") for (int r = 0; r < 16; ++r) { S0[r] = 0.f; S1[r] = 0.f; } \
    __builtin_amdgcn_sched_barrier(0); \
    _Pragma("unroll") for (int sl = 0; sl < 4; ++sl) { S0 = MFMA32(kq0[sl], qf[sl], S0); S1 = MFMA32(kq1[sl], qf[sl], S1); } } while (0)
#define AT_SOFTMAX(DIAG) do { \
    const int dj = jt * 64 + 8 * hl - iq; \
    const float dls = slope2 * (float)(jt * 64 - iq) - mrun; \
    const f32x2 dl0 = {dls, dls}, dl1 = {dls + slope2 * 32.f, dls + slope2 * 32.f}; \
    float mx = -1e30f; \
    _Pragma("unroll") for (int i = 0; i < 8; ++i) { \
      const int kof = 16 * ((2 * i) >> 3) + ((2 * i) & 7); \
      f32x2 u0 = (f32x2){S0[2 * i], S0[2 * i + 1]} * c1v + (kb[i] + dl0), u1 = (f32x2){S1[2 * i], S1[2 * i + 1]} * c1v + (kb[i] + dl1); \
      if (DIAG) { if (dj + kof > 0) u0.x = -1e30f; if (dj + kof + 1 > 0) u0.y = -1e30f; if (dj + 32 + kof > 0) u1.x = -1e30f; if (dj + 33 + kof > 0) u1.y = -1e30f; } \
      S0[2 * i] = u0.x; S0[2 * i + 1] = u0.y; S1[2 * i] = u1.x; S1[2 * i + 1] = u1.y; \
      mx = fmaxf(fmaxf(mx, u0.x), fmaxf(u0.y, fmaxf(u1.x, u1.y))); } \
    mx = fmaxf(mx, __shfl_xor(mx, 32)); \
    live = first || !__all(mx < -60.f);     \
    if (!live) break; \
    if (__any(mx > 8.f) || first) { \
      const float inc = first ? mx : fmaxf(mx, 0.f), al = first ? 0.f : __builtin_amdgcn_exp2f(-inc);     \
      mrun += inc; lrun *= al; \
      _Pragma("unroll") for (int dt = 0; dt < 4; ++dt) _Pragma("unroll") for (int r = 0; r < 16; ++r) O[dt][r] *= al; \
      _Pragma("unroll") for (int r = 0; r < 16; ++r) { S0[r] -= inc; S1[r] -= inc; } } \
    f32x2 ls2 = {0.f, 0.f}; \
    _Pragma("unroll") for (int i = 0; i < 8; ++i) { \
      const f32x2 p0 = {__builtin_amdgcn_exp2f(S0[2 * i]), __builtin_amdgcn_exp2f(S0[2 * i + 1])}, p1 = {__builtin_amdgcn_exp2f(S1[2 * i]), __builtin_amdgcn_exp2f(S1[2 * i + 1])}; \
      S0[2 * i] = p0.x; S0[2 * i + 1] = p0.y; S1[2 * i] = p1.x; S1[2 * i + 1] = p1.y; ls2 += p0 + p1; } \
    lrun += ls2.x + ls2.y; \
    pf[0] = pack8(S0, 0); pf[1] = pack8(S0, 1); pf[2] = pack8(S1, 0); pf[3] = pack8(S1, 1); } while (0)
#define AT_VLD(dst, vbuf_, ks) _Pragma("unroll") for (int dt = 0; dt < 4; ++dt) dst[dt] = *(const bf16x8*)((vbuf_) + dt * 4096 + (vread ^ (unsigned)((ks) << 5)))
#define AT_VMM(src, ks) _Pragma("unroll") for (int dt = 0; dt < 4; ++dt) O[dt] = MFMA32(src[dt], pf[ks], O[dt])
#define AT_PV(vbuf_) do { \
    bf16x8 va[4], vb[4]; \
    AT_VLD(va, vbuf_, 0); AT_VLD(vb, vbuf_, 1); \
    __builtin_amdgcn_sched_barrier(0); \
    __builtin_amdgcn_s_setprio(1); \
    AT_VMM(va, 0); AT_VLD(va, vbuf_, 2); \
    __builtin_amdgcn_sched_barrier(0); \
    AT_VMM(vb, 1); AT_VLD(vb, vbuf_, 3); \
    __builtin_amdgcn_sched_barrier(0); \
    AT_VMM(va, 2); AT_VMM(vb, 3); \
    __builtin_amdgcn_s_setprio(0); } while (0)
  f32x16 S0, S1;
  bf16x8 pf[4];
  int kcur = 0;
  bool live = false, pend = false;
  __syncthreads();
  AT_STAGE(AT_K0, AT_V0, nt - 1);
  AT_STAGE(AT_K0 + 16384, AT_V0 + 16384, nt - 2);
  asm volatile("s_waitcnt vmcnt(4)" ::: "memory");
  LBAR();
  for (int it = 0; it < nt; ++it) {
    const int jt = nt - 1 - it;
    const bool first = (jt == wnt - 1);
    unsigned char* kbuf = smem + AT_K0 + kcur * 16384;
    unsigned char* vbuf = smem + AT_V0 + (it & 3) * 16384;
    const int k2 = (kcur == 0) ? 2 : kcur - 1;
    if (it + 2 < nt) AT_STAGE(AT_K0 + k2 * 16384, AT_V0 + ((it + 2) & 3) * 16384, jt - 2);
    if (mp == 0) {
      if (jt < wnt) {
        AT_QK(kbuf);
        if (jt * 64 + 63 > q0) AT_SOFTMAX(1); else AT_SOFTMAX(0);
        if (live) AT_PV(vbuf);
      }
    } else {
      if (jt < wnt) AT_QK(kbuf);
      if (pend) AT_PV(smem + AT_V0 + ((it - 1) & 3) * 16384);
      pend = false;
      if (jt < wnt) { if (jt * 64 + 63 > q0) AT_SOFTMAX(1); else AT_SOFTMAX(0); pend = live; }
    }
    kcur = (kcur == 2) ? 0 : kcur + 1;
    if (it + 2 < nt) asm volatile("s_waitcnt vmcnt(4)" ::: "memory"); else asm volatile("s_waitcnt vmcnt(0)" ::: "memory");
    LBAR();
  }
  if (mp == 1 && pend) AT_PV(smem + AT_V0 + ((nt - 1) & 3) * 16384);
  __syncthreads();
#undef AT_STAGE
#undef AT_QK
#undef AT_SOFTMAX
#undef AT_PV
#undef AT_VLD
#undef AT_VMM
  const float lt = lrun + __shfl_xor(lrun, 32);
  const float sc = (mp ? lam : 1.f) / lt;
  float* xch = (float*)(smem + qg * 16384);
  if (mp == 1) {
#pragma unroll
    for (int dt = 0; dt < 4; ++dt)
#pragma unroll
      for (int g = 0; g < 4; ++g)
        *(f32x4*)(xch + ((dt * 4 + g) * 64 + lane) * 4) = (f32x4){O[dt][4 * g] * sc, O[dt][4 * g + 1] * sc, O[dt][4 * g + 2] * sc, O[dt][4 * g + 3] * sc};
  }
  __syncthreads();
  if (mp == 0) {
    float ss = 0.f;
#pragma unroll
    for (int dt = 0; dt < 4; ++dt)
#pragma unroll
      for (int g = 0; g < 4; ++g) {
        const f32x4 o2 = *(const f32x4*)(xch + ((dt * 4 + g) * 64 + lane) * 4);
#pragma unroll
        for (int j = 0; j < 4; ++j) { const float o = O[dt][4 * g + j] * sc - o2[j]; O[dt][4 * g + j] = o; ss += o * o; }
      }
    ss += __shfl_xor(ss, 32);
    const float rn = rsqrtf(ss * (1.f / 128.f) + EPS) * 0.8f;
    const bf16_t* zp = p.proj + (tokb + iq) * NP + C_DZ + hd * 128 + 4 * hl;
    bf16_t* mo = p.mix + (tokb + iq) * 1024 + 512 + hd * 128 + 4 * hl;
    const float* gp = p.diff_gain + hd * 128 + 4 * hl;
#pragma unroll
    for (int dt = 0; dt < 4; ++dt)
#pragma unroll
      for (int g = 0; g < 4; ++g) {
        const int dv = dt * 32 + 8 * g;
        const u32x2 zz = *(const u32x2*)(zp + dv); const f32x4 gn = *(const f32x4*)(gp + dv);
        const float y0 = O[dt][4 * g + 0] * rn * gn[0] * bf_lo(zz.x), y1 = O[dt][4 * g + 1] * rn * gn[1] * bf_hi(zz.x);
        const float y2 = O[dt][4 * g + 2] * rn * gn[2] * bf_lo(zz.y), y3 = O[dt][4 * g + 3] * rn * gn[3] * bf_hi(zz.y);
        u32x2 w; w.x = pk_bf16(y0, y1); w.y = pk_bf16(y2, y3);
        *(u32x2*)(mo + dv) = w;
      }
  }
}

constexpr int GL_QIN = 0, GL_KIN = 8192, GL_KST = 16384, GL_DEC = 24576, GL_CS = 24832, GL_XST = 26880, GL_OSQ = 43264, GL_PF = 44288;
constexpr int GP_VT = 0, GP_Q = 16384, GP_K = 24576, GP_LA = 32768, GP_SZ = 49152;
DI unsigned sw128(int row, int chunk) { return (unsigned)(row * 128 + ((chunk ^ ((row >> 1) & 7)) << 4)); }

DI void gla_item(const Params& p, const int bh, unsigned char* smem, const int t) {
  const int lane = t & 63, wid = t >> 6, r32 = lane & 31, hl = lane >> 5;
  const int vt = wid & 3, kt = wid >> 2, it = kt;
  const int b = bh >> 2, hd = bh & 3;
  const size_t tokb = (size_t)b * SEQ;
  const int d = lane, jg = wid, col = hd * 64 + d;
  f32x16 St;
#pragma unroll
  for (int r = 0; r < 16; ++r) St[r] = 0.f;
  const int L0 = wid * 128 + lane, L1 = L0 + 64, vr0 = L0 >> 3, vr1 = L1 >> 3;
  const bf16_t* vg0 = p.gvT + ((size_t)bh * 128 + vr0) * SEQ + (((L0 & 7) ^ ((vr0 >> 1) & 7)) << 3);
  const bf16_t* vg1 = p.gvT + ((size_t)bh * 128 + vr1) * SEQ + (((L1 & 7) ^ ((vr1 >> 1) & 7)) << 3);
  const int Lq = wid * 64 + lane;
  const bf16_t* qg = p.proj + (tokb + (Lq >> 3)) * NP + C_GQ + hd * 64 + (Lq & 7) * 8;
  const bf16_t* kg = p.proj + (tokb + (Lq >> 3)) * NP + C_GK + hd * 64 + (Lq & 7) * 8;
  const int La0 = wid * 128 + lane, La1 = La0 + 64;
  const float* lag0 = p.la + (tokb + (La0 >> 4)) * 256 + hd * 64 + (La0 & 15) * 4;
  const float* lag1 = p.la + (tokb + (La1 >> 4)) * 256 + hd * 64 + (La1 & 15) * 4;
#define GL_STAGE(bufo, ch_) do { \
    __builtin_amdgcn_global_load_lds((const unsigned*)(vg0 + (ch_) * 64), (unsigned*)(smem + (bufo) + GP_VT + wid * 2048), 16, 0, 0); \
    __builtin_amdgcn_global_load_lds((const unsigned*)(vg1 + (ch_) * 64), (unsigned*)(smem + (bufo) + GP_VT + wid * 2048 + 1024), 16, 0, 0); \
    __builtin_amdgcn_global_load_lds((const unsigned*)(qg + (size_t)(ch_) * 64 * NP), (unsigned*)(smem + (bufo) + GP_Q + wid * 1024), 16, 0, 0); \
    __builtin_amdgcn_global_load_lds((const unsigned*)(kg + (size_t)(ch_) * 64 * NP), (unsigned*)(smem + (bufo) + GP_K + wid * 1024), 16, 0, 0); \
    __builtin_amdgcn_global_load_lds((const unsigned*)(lag0 + (size_t)(ch_) * 64 * 256), (unsigned*)(smem + (bufo) + GP_LA + wid * 2048), 16, 0, 0); \
    __builtin_amdgcn_global_load_lds((const unsigned*)(lag1 + (size_t)(ch_) * 64 * 256), (unsigned*)(smem + (bufo) + GP_LA + wid * 2048 + 1024), 16, 0, 0); } while (0)
  const int krow = swap23(r32);
  const int qi = it * 32 + r32;
  float* cs = (float*)(smem + GL_CS); float* dec = (float*)(smem + GL_DEC); float* osq = (float*)(smem + GL_OSQ);
  const int v0 = hd * 128 + vt * 32 + 4 * hl;
  f32x4 gnv[4];
#pragma unroll
  for (int g = 0; g < 4; ++g) gnv[g] = *(const f32x4*)(p.gla_gain + v0 + 8 * g);
  __syncthreads();
  GL_STAGE(GL_PF, 0);
  asm volatile("s_waitcnt vmcnt(0)" ::: "memory");
  __syncthreads();
  for (int ch = 0; ch < SEQ / 64; ++ch) {
    const size_t tok0 = tokb + (size_t)ch * 64;
    unsigned char* pb = smem + GL_PF + (ch & 1) * GP_SZ;
    if (ch + 1 < SEQ / 64) GL_STAGE(GL_PF + ((ch + 1) & 1) * GP_SZ, ch + 1);
    const bf16_t* zp = p.proj + (tok0 + qi) * NP + C_GZ + v0;
    u32x2 zz[4];
#pragma unroll
    for (int g = 0; g < 4; ++g) zz[g] = *(const u32x2*)(zp + 8 * g);
    float la[8], qv[8], kv[8];
    {
      float run = 0.f;
#pragma unroll
      for (int e = 0; e < 8; ++e) {
        const int j = jg * 8 + e;
        run += *(const float*)(pb + GP_LA + j * 256 + d * 4); la[e] = run;
        qv[e] = bf2f(*(const bf16_t*)(pb + GP_Q + j * 128 + d * 2)); kv[e] = bf2f(*(const bf16_t*)(pb + GP_K + j * 128 + d * 2));
      }
      cs[jg * 64 + d] = run;
    }
    LBAR();
    {
      float pre = 0.f, tot = 0.f;
#pragma unroll
      for (int g = 0; g < 8; ++g) { const float c = cs[g * 64 + d]; tot += c; if (g < jg) pre += c; }
      const float etot = __builtin_amdgcn_exp2f(tot * 1.44269504f);
      float ks[8];
#pragma unroll
      for (int e = 0; e < 8; ++e) {
        const int j = jg * 8 + e; const float bc = pre + la[e];
        const float eb = __builtin_amdgcn_exp2f(bc * 1.44269504f), ib = __builtin_amdgcn_rcpf(eb);
        const float qin = qv[e] * 0.125f * eb, kin = kv[e] * ib;
        ks[e] = kin * etot;
        const unsigned off = sw128(j, d >> 3) + ((d & 7) << 1);
        *(bf16_t*)(smem + GL_QIN + off) = (bf16_t)(pk_bf16(qin, 0.f) & 0xffff);
        *(bf16_t*)(smem + GL_KIN + off) = (bf16_t)(pk_bf16(kin, 0.f) & 0xffff);
      }
      u32x4 w; w.x = pk_bf16(ks[0], ks[1]); w.y = pk_bf16(ks[2], ks[3]); w.z = pk_bf16(ks[4], ks[5]); w.w = pk_bf16(ks[6], ks[7]);
      *(u32x4*)(smem + GL_KST + sw128(d, jg)) = w;
      if (jg == 0) dec[d] = etot;
      *(bf16x8*)(smem + GL_XST + ((wid * 2 + 0) * 64 + lane) * 16) = pack8(St, 0);
      *(bf16x8*)(smem + GL_XST + ((wid * 2 + 1) * 64 + lane) * 16) = pack8(St, 1);
    }
    LBAR();
    f32x16 Oacc;
#pragma unroll
    for (int r = 0; r < 16; ++r) Oacc[r] = 0.f;
#pragma unroll
    for (int js = 0; js < 2; ++js) {
      if (js > it) continue;
      f32x16 S;
#pragma unroll
      for (int r = 0; r < 16; ++r) S[r] = 0.f;
#pragma unroll
      for (int sl = 0; sl < 4; ++sl) {
        const bf16x8 af = *(const bf16x8*)(smem + GL_KIN + sw128(js * 32 + krow, sl * 2 + hl));
        const bf16x8 bq = *(const bf16x8*)(smem + GL_QIN + sw128(qi, sl * 2 + hl));
        S = MFMA32(af, bq, S);
      }
      if (js == it) {
#pragma unroll
        for (int r = 0; r < 16; ++r) { const int kof = 16 * (r >> 3) + (r & 7) + 8 * hl; if (kof > r32) S[r] = 0.f; }
      }
      const bf16x8 pf0 = pack8(S, 0), pf1 = pack8(S, 1);
      const bf16x8 va = *(const bf16x8*)(pb + GP_VT + sw128(vt * 32 + r32, js * 4 + 0 + hl));
      const bf16x8 vb = *(const bf16x8*)(pb + GP_VT + sw128(vt * 32 + r32, js * 4 + 2 + hl));
      Oacc = MFMA32(va, pf0, Oacc); Oacc = MFMA32(vb, pf1, Oacc);
    }
#pragma unroll
    for (int kk = 0; kk < 2; ++kk)
#pragma unroll
      for (int s2 = 0; s2 < 2; ++s2) {
        const bf16x8 sf = *(const bf16x8*)(smem + GL_XST + (((kk * 4 + vt) * 2 + s2) * 64 + lane) * 16);
        const bf16x8 bq = *(const bf16x8*)(smem + GL_QIN + sw128(qi, kk * 4 + s2 * 2 + hl));
        Oacc = MFMA32(sf, bq, Oacc);
      }
    {
      const float* dp = dec + kt * 32 + 8 * hl;
      const f32x4 d0 = *(const f32x4*)(dp), d1 = *(const f32x4*)(dp + 4), d2 = *(const f32x4*)(dp + 16), d3 = *(const f32x4*)(dp + 20);
#pragma unroll
      for (int j = 0; j < 4; ++j) { St[j] *= d0[j]; St[4 + j] *= d1[j]; St[8 + j] *= d2[j]; St[12 + j] *= d3[j]; }
#pragma unroll
      for (int ks = 0; ks < 4; ++ks) {
        const bf16x8 af = *(const bf16x8*)(smem + GL_KST + sw128(kt * 32 + krow, ks * 2 + hl));
        const bf16x8 bv = *(const bf16x8*)(pb + GP_VT + sw128(vt * 32 + r32, ks * 2 + hl));
        St = MFMA32(af, bv, St);
      }
    }
    {
      float ss = 0.f;
#pragma unroll
      for (int r = 0; r < 16; ++r) ss += Oacc[r] * Oacc[r];
      ss += __shfl_xor(ss, 32);
      if (hl == 0) osq[vt * 64 + qi] = ss;
    }
    asm volatile("s_waitcnt vmcnt(0)" ::: "memory");
    LBAR();
    {
      const float tot = osq[qi] + osq[64 + qi] + osq[128 + qi] + osq[192 + qi];
      const float rn = rsqrtf(tot * (1.f / 128.f) + EPS);
      bf16_t* mo = p.mix + (tok0 + qi) * 1024 + v0;
#pragma unroll
      for (int g = 0; g < 4; ++g) {
        const f32x4 gn = gnv[g];
        const float y0 = Oacc[4 * g + 0] * rn * gn[0] * bf_lo(zz[g].x), y1 = Oacc[4 * g + 1] * rn * gn[1] * bf_hi(zz[g].x);
        const float y2 = Oacc[4 * g + 2] * rn * gn[2] * bf_lo(zz[g].y), y3 = Oacc[4 * g + 3] * rn * gn[3] * bf_hi(zz[g].y);
        u32x2 w; w.x = pk_bf16(y0, y1); w.y = pk_bf16(y2, y3);
        *(u32x2*)(mo + 8 * g) = w;
      }
    }
  }
#undef GL_STAGE
}

DI void mixer_phase(const Params& p, unsigned char* smem, const int t, const int cidx = 0, const int first = 0, const int limit = 100000) {
  const float lam = lam_value(p, t);
  constexpr int N_GLA = 64, N_ATT = 64 * 16;
  volatile int* sitem = (volatile int*)(smem + LDS_BYTES - 16);
  for (;;) {
    __syncthreads();
    if (t == 0) *sitem = first + (int)atomicAdd(p.ctr + cidx, 1u);
    __syncthreads();
    const int item = *sitem;
    if (item >= N_GLA + N_ATT || item >= limit) break;
#ifndef NO_GLA
    if (item < N_GLA) gla_item(p, item, smem, fresh_tid());
#endif
#ifndef NO_ATT
    if (item >= N_GLA) { const int a = item - N_GLA; attn_item(p, a & 63, 15 - (a >> 6), lam, smem, fresh_tid()); }
#endif
  }
}

DI void final_phase(const Params& p, const int t) {
  const size_t n4 = (size_t)NTOK * 1024 / 4;
  for (size_t i = (size_t)blockIdx.x * NTHREADS + t; i < n4; i += (size_t)gridDim.x * NTHREADS) {
    const size_t row = i >> 8; const int c4 = (int)(i & 255) * 4;
    const float r = rsqrtf(p.rowsq[row] * (1.f / 1024.f) + EPS);
    const f32x4 y = *(const f32x4*)(p.out + i * 4), gv = *(const f32x4*)(p.final_gain + c4);
    *(f32x4*)(p.out + i * 4) = y * r * gv;
  }
}

typedef const __attribute__((address_space(4))) Params* ParamsK;
DI Params fresh_params() {
#if defined(__HIP_DEVICE_COMPILE__)
  ParamsK kp = (ParamsK)__builtin_amdgcn_kernarg_segment_ptr(); asm volatile("" : "+s"(kp));
  Params r; __builtin_memcpy_inline(&r, kp, sizeof(Params)); return r;
#else
  return Params{};
#endif
}

__global__ void __launch_bounds__(NTHREADS, 2) fwd_kernel(Params p_) {
  extern __shared__ __attribute__((aligned(16))) unsigned char smem[];
  cg::grid_group grid = cg::this_grid();
  const int lo = p_.phase_lo, hi = p_.phase_hi;
  if (hi == 99) grid.sync();
  volatile LAS unsigned* st = (volatile LAS unsigned*)(smem + LDS_BYTES - 32);
  if (lo < hi) {
    if (threadIdx.x == 0) { st[0] = 0u; st[1] = 0u; (void)xb_add(&p_.bar[XB_XCNT(xb_xcc_id())], 1u); }
    __syncthreads();
  }
#define SEAM(a_) do { if (lo <= (a_) && (a_) + 1 <= hi) { const Params pb = fresh_params(); xcd_barrier(pb.bar, st); } } while (0)
#ifndef PHM
#define PHM 63
#endif
  if ((PHM & 1) && lo <= 0 && 0 <= hi) { const Params p = fresh_params(); phase0a(p, smem, fresh_tid()); }
  SEAM(0);
  if ((PHM & 2) && lo <= 1 && 1 <= hi) { const Params p = fresh_params(); phase0b(p, smem, fresh_tid()); }
  SEAM(1);
  if ((PHM & 4) && lo <= 2 && 2 <= hi) { const Params p = fresh_params(); gemm1_phase(p); }
  SEAM(2);
  if ((PHM & 8) && lo <= 3 && 3 <= hi) { const Params p = fresh_params(); mixer_phase(p, smem, fresh_tid()); }
  SEAM(3);
  if ((PHM & 16) && lo <= 4 && 4 <= hi) { const Params p = fresh_params(); gemm2_phase(p); }
}

extern "C" void kernel_launch(void* const* d_in, const int* in_sizes, int n_in, void* d_out, int out_size, void* d_ws, size_t ws_size, hipStream_t stream) {
  static int grid_blocks = 0;
  if (!grid_blocks) {
    hipFuncSetAttribute((const void*)fwd_kernel, hipFuncAttributeMaxDynamicSharedMemorySize, LDS_BYTES);
    int dev = 0, cus = 0, per_cu = 0;
    hipGetDevice(&dev);
    hipDeviceGetAttribute(&cus, hipDeviceAttributeMultiprocessorCount, dev);
    hipOccupancyMaxActiveBlocksPerMultiprocessor(&per_cu, fwd_kernel, NTHREADS, LDS_BYTES);
    if (per_cu < 1) per_cu = 1;
    grid_blocks = cus * per_cu;
  }
  Params p{};
  p.x = (const float*)d_in[0]; p.c = (const float*)d_in[1]; p.w_ada = (const float*)d_in[2]; p.b_ada = (const float*)d_in[3];
  p.norm_gain = (const float*)d_in[4]; p.w_in = (const float*)d_in[5]; p.w_up = (const float*)d_in[6]; p.b_gate = (const float*)d_in[7];
  p.gla_gain = (const float*)d_in[8]; p.lq1 = (const float*)d_in[9]; p.lk1 = (const float*)d_in[10]; p.lq2 = (const float*)d_in[11];
  p.lk2 = (const float*)d_in[12]; p.diff_gain = (const float*)d_in[13]; p.w_out = (const float*)d_in[14]; p.final_gain = (const float*)d_in[15];
  p.out = (float*)d_out;
  unsigned char* w = (unsigned char*)d_ws; size_t off = 0;
  auto take = [&](size_t bytes) { void* r = w + off; off += (bytes + 255) & ~(size_t)255; return r; };
  p.modpart = (float*)take((size_t)8 * 16 * 3072 * 4);
  p.mod = (float*)take((size_t)16 * 3072 * 4);
  p.rowsq = (float*)take((size_t)NTOK * 4);
  p.la = (float*)take((size_t)NTOK * 256 * 4);
  p.winT = (bf16_t*)take((size_t)NP * 1024 * 2);
  p.woutT = (bf16_t*)take((size_t)1024 * 1024 * 2);
  p.h = (bf16_t*)take((size_t)NTOK * 1024 * 2);
  p.proj = (bf16_t*)take((size_t)NTOK * NP * 2);
  p.mix = (bf16_t*)take((size_t)NTOK * 1024 * 2);
  p.gvT = (bf16_t*)take((size_t)NTOK * 512 * 2);
  p.dvT = (bf16_t*)take((size_t)NTOK * 512 * 2);
  p.bar = (unsigned*)take((size_t)XCD_BAR_WORDS * 4 + 1024);
  p.ctr = p.bar + XCD_BAR_WORDS;
  p.pcnt = p.ctr + 64;
#if 0
  hipMemsetAsync(p.bar, 0, (size_t)XCD_BAR_WORDS * 4 + 1024, stream);
  for (int ph = 0; ph < 5; ++ph) {
    p.phase_lo = ph; p.phase_hi = ph;
    hipLaunchKernelGGL(fwd_kernel, dim3(grid_blocks), dim3(NTHREADS), LDS_BYTES, stream, p);
  }
#else
  p.phase_lo = 0; p.phase_hi = 4;
  hipMemsetAsync(p.bar, 0, (size_t)XCD_BAR_WORDS * 4 + 1024, stream);
  void* args[] = {&p};
  hipError_t e = hipLaunchCooperativeKernel((void*)fwd_kernel, dim3(grid_blocks), dim3(NTHREADS), args, LDS_BYTES, stream);
  if (e != hipSuccess) fprintf(stderr, "cooperative launch failed: %s (grid %d)\n", hipGetErrorString(e), grid_blocks);
#endif
}
```

```cpp
#include <hip/hip_runtime.h>
#include <hip/hip_cooperative_groups.h>
#include <cstdio>
#include <cstdint>
namespace cg = cooperative_groups;

typedef unsigned short bf16_t;
typedef short bf16x8 __attribute__((ext_vector_type(8)));
typedef float f32x4 __attribute__((ext_vector_type(4)));
typedef float f32x2 __attribute__((ext_vector_type(2)));
typedef __bf16 bf16v2 __attribute__((ext_vector_type(2)));
typedef unsigned u32x4 __attribute__((ext_vector_type(4)));
typedef unsigned u32x2 __attribute__((ext_vector_type(2)));

#define DI __device__ __forceinline__

constexpr int D_MODEL = 1024, BATCH = 16, SEQ = 2048, NTOK = BATCH * SEQ;
constexpr int D_IN = 3600, NP = 3584;
constexpr int C_GQ = 0, C_GK = 256, C_GV = 512, C_GZ = 1024, C_DQ = 1536, C_DK = 2048, C_DV = 2560, C_DZ = 3072;
constexpr int NTHREADS = 512;
constexpr int LDS_BYTES = 147456;
constexpr float EPS = 1e-6f;

struct Params {
  const float *x, *c, *w_ada, *b_ada, *norm_gain, *w_in, *w_up, *b_gate, *gla_gain, *lq1, *lk1, *lq2, *lk2, *diff_gain, *w_out, *final_gain;
  float* out;
  float* modpart;
  float* mod;
  float* rowsq;
  float* la;
  bf16_t* winT;
  bf16_t* woutT;
  bf16_t* h;
  bf16_t* proj;
  bf16_t* mix;
  bf16_t* gvT;
  bf16_t* dvT;
  unsigned* ctr;
  unsigned* bar;
  unsigned* pcnt;
  int phase_lo, phase_hi;
};

DI unsigned pk_bf16(float a, float b) { f32x2 v = {a, b}; bf16v2 r = __builtin_convertvector(v, bf16v2); return __builtin_bit_cast(unsigned, r); }
DI float bf_lo(unsigned u) { return __uint_as_float(u << 16); }
DI float bf_hi(unsigned u) { return __uint_as_float(u & 0xffff0000u); }
DI float bf2f(bf16_t u) { return __uint_as_float(((unsigned)u) << 16); }
DI float wave_sum(float v) {
#pragma unroll
  for (int o = 32; o >= 1; o >>= 1) v += __shfl_xor(v, o);
  return v;
}
DI float wave_max(float v) {
#pragma unroll
  for (int o = 32; o >= 1; o >>= 1) v = fmaxf(v, __shfl_xor(v, o));
  return v;
}
DI float silu_f(float v) { return v * __builtin_amdgcn_rcpf(1.f + __builtin_amdgcn_exp2f(-1.44269504f * v)); }

#define XB_TMO      128
#define XB_XCNT(j)  (256  + 64 * (j))
#define XB_XSUB(j)  (1280 + 64 * (j))
#define XB_XGEN(j)  (2304 + 64 * (j))
#define XB_TOP      3328
#define XB_TOPGEN   3392
#define XCD_BAR_WORDS 3456
#define XB_SPIN_CAP (1u << 20)
#define LAS __attribute__((address_space(3)))
DI unsigned xb_ld(unsigned* p)              { return __hip_atomic_load(p, __ATOMIC_RELAXED, __HIP_MEMORY_SCOPE_AGENT); }
DI unsigned xb_add(unsigned* p, unsigned v) { return __hip_atomic_fetch_add(p, v, __ATOMIC_RELAXED, __HIP_MEMORY_SCOPE_AGENT); }
DI unsigned xb_xcc_id() { return (unsigned)__builtin_amdgcn_s_getreg((3 << 11) | 20) & 0xFu; }
#define XB_SPIN(cond, bar) do { unsigned _sp = 0; while (cond) { __builtin_amdgcn_s_sleep(1); \
    if ((++_sp & 255u) == 0u) { if (xb_ld(&(bar)[XB_TMO])) break; if (_sp > XB_SPIN_CAP) { atomicAdd(&(bar)[XB_TMO], 1u); break; } } } } while (0)
DI void xcd_barrier_complete(unsigned* bar, unsigned x, unsigned& nloc, unsigned& nx) {
  const unsigned G = gridDim.x;
  unsigned sum, cnt, mine, sp = 0u;
  for (;;) {
    sum = 0u; cnt = 0u; mine = 0u;
#pragma unroll
    for (unsigned j = 0; j < 16; ++j) { const unsigned c = xb_ld(&bar[XB_XCNT(j)]); sum += c; cnt += (c > 0u) ? 1u : 0u; mine = (j == x) ? c : mine; }
    if (sum == G) break;
    __builtin_amdgcn_s_sleep(1);
    if ((++sp & 255u) == 0u) { if (xb_ld(&bar[XB_TMO])) break; if (sp > XB_SPIN_CAP) { atomicAdd(&bar[XB_TMO], 1u); break; } }
  }
  nloc = mine > 0u ? mine : 1u; nx = cnt > 0u ? cnt : 1u;
}
DI void xcd_barrier(unsigned* bar, volatile LAS unsigned* st) {
  asm volatile("s_waitcnt vmcnt(0)" ::: "memory");
  __syncthreads();
  if (threadIdx.x == 0) {
    const unsigned x = xb_xcc_id();
    __builtin_amdgcn_s_waitcnt(0);
    unsigned nloc = st[0], nx = st[1];
    if (nloc == 0u) { xcd_barrier_complete(bar, x, nloc, nx); st[0] = nloc; st[1] = nx; }
    const unsigned old = xb_add(&bar[XB_XSUB(x)], 1u);
    const unsigned gen = old / nloc;
    if (old + 1u == (gen + 1u) * nloc) {
      __builtin_amdgcn_fence(__ATOMIC_RELEASE, "agent");
      asm volatile("s_waitcnt vmcnt(0)" ::: "memory");
      const unsigned og = xb_add(&bar[XB_TOP], 1u);
      const unsigned tg = og / nx;
      if (og + 1u == (tg + 1u) * nx) xb_add(&bar[XB_TOPGEN], 1u);
      else XB_SPIN(xb_ld(&bar[XB_TOPGEN]) == tg, bar);
      __builtin_amdgcn_fence(__ATOMIC_ACQUIRE, "agent");
      xb_add(&bar[XB_XGEN(x)], 1u);
      asm volatile("s_waitcnt vmcnt(0)" ::: "memory");
    } else {
      XB_SPIN(xb_ld(&bar[XB_XGEN(x)]) == gen, bar);
      __builtin_amdgcn_fence(__ATOMIC_ACQUIRE, "agent");
      asm volatile("s_waitcnt vmcnt(0)" ::: "memory");
    }
  }
  __syncthreads();
}

DI int fresh_tid() { int t = threadIdx.x; asm volatile("" : "+v"(t)); return t; }

DI int perm32(int r) { return 8 * ((r & 15) >> 2) + 4 * (r >> 4) + (r & 3); }
DI int inv32(int a) { return ((a >> 2) & 1) * 16 + (a >> 3) * 4 + (a & 3); }

DI void phase0a(const Params& p, unsigned char* smem, const int t) {
  for (int i = blockIdx.x * NTHREADS + t; i < NTOK; i += gridDim.x * NTHREADS) p.rowsq[i] = 0.f;
  constexpr int N_MOD = 192, N_WIN = 16 * 56, N_WOUT = 16 * 16;
  for (int item = blockIdx.x; item < N_MOD + N_WIN + N_WOUT; item += gridDim.x) {
    __syncthreads();
    if (item < N_MOD) {
      const int nc = item % 24, ks = item / 24, n0 = nc * 128, k0 = ks * 128;
      float* sc = (float*)smem;
      float* red = sc + 16 * 128;
      for (int e = t; e < 2048; e += NTHREADS) { const int b = e >> 7, kk = e & 127; sc[e] = silu_f(p.c[b * 1024 + k0 + kk]); }
      __syncthreads();
      const int nl = t & 127, sub = t >> 7;
      float acc[16];
#pragma unroll
      for (int b = 0; b < 16; ++b) acc[b] = 0.f;
      for (int kk = sub * 32; kk < sub * 32 + 32; ++kk) {
        const float w = p.w_ada[(size_t)(k0 + kk) * 3072 + n0 + nl];
#pragma unroll
        for (int b = 0; b < 16; ++b) acc[b] += sc[b * 128 + kk] * w;
      }
#pragma unroll
      for (int b = 0; b < 16; ++b) red[(sub * 16 + b) * 128 + nl] = acc[b];
      __syncthreads();
      for (int e = t; e < 2048; e += NTHREADS) {
        const int b = e >> 7, n = e & 127;
        p.modpart[((size_t)ks * 16 + b) * 3072 + n0 + n] = red[(0 * 16 + b) * 128 + n] + red[(1 * 16 + b) * 128 + n] + red[(2 * 16 + b) * 128 + n] + red[(3 * 16 + b) * 128 + n];
      }
    } else {
      const float* src; bf16_t* dst; int ld, k0, n0, ncol;
      if (item < N_MOD + N_WIN) { const int it = item - N_MOD; k0 = (it % 16) * 64; n0 = (it / 16) * 64; src = p.w_in; ld = D_IN; dst = p.winT; ncol = n0 < C_DQ ? n0 : n0 + 16; }
      else { const int it = item - N_MOD - N_WIN; k0 = (it % 16) * 64; n0 = (it / 16) * 64; src = p.w_out; ld = 1024; dst = p.woutT; ncol = n0; }
      float* tile = (float*)smem;
#pragma unroll
      for (int e = 0; e < 8; ++e) { const int idx = e * NTHREADS + t, r = idx >> 6, cc = idx & 63; tile[r * 65 + cc] = src[(size_t)(k0 + r) * ld + ncol + cc]; }
      __syncthreads();
      const int n = t >> 3, ksg = (t & 7) * 8;
      const int ns = (src == p.w_in) ? ((n & ~31) | perm32(n & 31)) : n;
      u32x4 w;
      w.x = pk_bf16(tile[(ksg + 0) * 65 + ns], tile[(ksg + 1) * 65 + ns]);
      w.y = pk_bf16(tile[(ksg + 2) * 65 + ns], tile[(ksg + 3) * 65 + ns]);
      w.z = pk_bf16(tile[(ksg + 4) * 65 + ns], tile[(ksg + 5) * 65 + ns]);
      w.w = pk_bf16(tile[(ksg + 6) * 65 + ns], tile[(ksg + 7) * 65 + ns]);
      *(u32x4*)(dst + (size_t)(n0 + n) * 1024 + k0 + ksg) = w;
    }
  }
}

DI void phase0b(const Params& p, unsigned char* smem, const int t) {
  const int lane = t & 63, wid = t >> 6;
  for (int i = blockIdx.x * NTHREADS + t; i < 16 * 3072; i += gridDim.x * NTHREADS) {
    float s = p.b_ada[i % 3072];
#pragma unroll
    for (int ks = 0; ks < 8; ++ks) s += p.modpart[(size_t)ks * 16 * 3072 + i];
    p.mod[i] = s;
  }
  float* g = (float*)smem;
  float* sh = g + 1024;
  float* wg = sh + 1024;
  f32x4 wup[16];
#pragma unroll
  for (int r = 0; r < 16; ++r) wup[r] = *(const f32x4*)(p.w_up + r * 256 + lane * 4);
  const f32x4 bgv = *(const f32x4*)(p.b_gate + lane * 4);
  for (int item = blockIdx.x; item < NTOK / 128; item += gridDim.x) {
    const int b = item / 16, row0 = item * 128;
    __syncthreads();
    for (int k = t; k < 1024; k += NTHREADS) {
      float s_sh = p.b_ada[k], s_sc = p.b_ada[1024 + k];
#pragma unroll
      for (int ks = 0; ks < 8; ++ks) { s_sh += p.modpart[((size_t)ks * 16 + b) * 3072 + k]; s_sc += p.modpart[((size_t)ks * 16 + b) * 3072 + 1024 + k]; }
      g[k] = p.norm_gain[k] * (1.f + s_sc); sh[k] = s_sh;
    }
    for (int e = t; e < 4096; e += NTHREADS) {
      const int r = e & 15, L = (e >> 4) & 63, i = e >> 10, k = i * 256 + 4 * L;
      const float* wp = p.w_in + (size_t)k * D_IN + 1536 + r;
      u32x2 w; w.x = pk_bf16(wp[0], wp[D_IN]); w.y = pk_bf16(wp[2 * D_IN], wp[3 * D_IN]);
      *(u32x2*)((unsigned char*)wg + (i * 64 + L) * 128 + (((r >> 1) ^ ((L >> 1) & 7)) << 4) + (r & 1) * 8) = w;
    }
    __syncthreads();
    f32x4 xn[4];
#pragma unroll
    for (int i = 0; i < 4; ++i) xn[i] = __builtin_nontemporal_load((const f32x4*)(p.x + (size_t)(row0 + wid) * 1024 + i * 256 + lane * 4));
    for (int rr = wid; rr < 128; rr += 8) {
      const size_t row = row0 + rr;
      const size_t hrow = (row & ~(size_t)31) | (size_t)inv32((int)(row & 31));
      f32x4 xv[4];
#pragma unroll
      for (int i = 0; i < 4; ++i) xv[i] = xn[i];
      if (rr + 8 < 128) {
#pragma unroll
        for (int i = 0; i < 4; ++i) xn[i] = __builtin_nontemporal_load((const f32x4*)(p.x + (row + 8) * 1024 + i * 256 + lane * 4));
      }
      float ss = 0.f;
#pragma unroll
      for (int i = 0; i < 4; ++i) ss += xv[i][0] * xv[i][0] + xv[i][1] * xv[i][1] + xv[i][2] * xv[i][2] + xv[i][3] * xv[i][3];
      ss = wave_sum(ss);
      const float rstd = rsqrtf(ss * (1.f / 1024.f) + EPS);
      float pr[16];
#pragma unroll
      for (int r = 0; r < 16; ++r) pr[r] = 0.f;
#pragma unroll
      for (int i = 0; i < 4; ++i) {
        const int k = i * 256 + lane * 4;
        const f32x4 gv = *(const f32x4*)(g + k), sv = *(const f32x4*)(sh + k);
        const f32x4 hv = xv[i] * rstd * gv + sv;
        u32x2 w; w.x = pk_bf16(hv[0], hv[1]); w.y = pk_bf16(hv[2], hv[3]);
        *(u32x2*)(p.h + hrow * 1024 + k) = w;
        const unsigned char* wrow = (const unsigned char*)wg + (i * 64 + lane) * 128;
#pragma unroll
        for (int c = 0; c < 8; ++c) {
          const u32x4 wv = *(const u32x4*)(wrow + ((c ^ ((lane >> 1) & 7)) << 4));
          asm volatile("v_dot2c_f32_bf16 %0, %1, %2" : "+v"(pr[2 * c]) : "v"(w.x), "v"(wv.x));
          asm volatile("v_dot2c_f32_bf16 %0, %1, %2" : "+v"(pr[2 * c]) : "v"(w.y), "v"(wv.y));
          asm volatile("v_dot2c_f32_bf16 %0, %1, %2" : "+v"(pr[2 * c + 1]) : "v"(w.x), "v"(wv.z));
          asm volatile("v_dot2c_f32_bf16 %0, %1, %2" : "+v"(pr[2 * c + 1]) : "v"(w.y), "v"(wv.w));
        }
        __builtin_amdgcn_sched_barrier(0);
      }
      float a8[8], a4[4], a2[2], a1;
      { const bool hi = lane & 1;
#pragma unroll
        for (int i = 0; i < 8; ++i) { const float keep = hi ? pr[i + 8] : pr[i], send = hi ? pr[i] : pr[i + 8]; a8[i] = keep + __shfl_xor(send, 1); } }
      { const bool hi = lane & 2;
#pragma unroll
        for (int i = 0; i < 4; ++i) { const float keep = hi ? a8[i + 4] : a8[i], send = hi ? a8[i] : a8[i + 4]; a4[i] = keep + __shfl_xor(send, 2); } }
      { const bool hi = lane & 4;
#pragma unroll
        for (int i = 0; i < 2; ++i) { const float keep = hi ? a4[i + 2] : a4[i], send = hi ? a4[i] : a4[i + 2]; a2[i] = keep + __shfl_xor(send, 4); } }
      { const bool hi = lane & 8; const float keep = hi ? a2[1] : a2[0], send = hi ? a2[0] : a2[1]; a1 = keep + __shfl_xor(send, 8); }
      a1 += __shfl_xor(a1, 16); a1 += __shfl_xor(a1, 32);
      float* grs = (float*)(smem + 73728) + wid * 16;
      if (lane < 16) grs[8 * (lane & 1) + 4 * ((lane >> 1) & 1) + 2 * ((lane >> 2) & 1) + ((lane >> 3) & 1)] = a1;
      const f32x4 g0 = *(const f32x4*)(grs), g1 = *(const f32x4*)(grs + 4), g2 = *(const f32x4*)(grs + 8), g3 = *(const f32x4*)(grs + 12);
      f32x4 lg = bgv;
#pragma unroll
      for (int j = 0; j < 4; ++j) {
        lg += g0[j] * wup[j] + g1[j] * wup[4 + j] + g2[j] * wup[8 + j] + g3[j] * wup[12 + j];
      }
      f32x4 lav;
#pragma unroll
      for (int j = 0; j < 4; ++j) lav[j] = (fminf(lg[j], 0.f) - __logf(1.f + __expf(-fabsf(lg[j])))) * (1.f / 16.f);
      *(f32x4*)(p.la + row * 256 + lane * 4) = lav;
    }
  }
}

constexpr int BM = 256, BK = 64, HALF = 128, NXCD = 8, WGM = 8, HT = HALF * BK;
DI int lds_byte(int r, int c) { int st = (r >> 4) * 2 + (c >> 5), rr = r & 15, cc = c & 31, ob = rr * 64 + cc * 2; return st * 1024 + (ob ^ (((ob >> 9) & 1) << 5)); }
DI void stage_rc(int b, int& R, int& C) { int st = b / 1024, sb = b % 1024, swz = sb ^ (((sb >> 9) & 1) << 5); R = (st >> 1) * 16 + swz / 64; C = (st & 1) * 32 + (swz % 64) / 2; }

template <class Epi>
DI void gemm_tile(const bf16_t* __restrict__ A, const bf16_t* __restrict__ Bt, const int K, const int brow, const int bcol, const Epi& epi) {
  extern __shared__ __attribute__((aligned(16))) unsigned char smem[];
  bf16_t* shm = (bf16_t*)smem;
#define SA(b, h) (shm + ((b) * 2 + (h)) * HT)
#define SB(b, h) (shm + (4 + (b) * 2 + (h)) * HT)
#define STAGE(P, BASE, br, kt) do { const bf16_t* _gb = (BASE) + ((long)(br) * K + (long)(kt) * BK); \
    __builtin_amdgcn_global_load_lds((const unsigned*)(_gb + toff0), (unsigned*)((char*)(P) + tb16), 16, 0, 0); \
    __builtin_amdgcn_global_load_lds((const unsigned*)(_gb + toff1), (unsigned*)((char*)(P) + tb16 + 8192), 16, 0, 0); } while (0)
#define LDA(dst, b, h) for (int m = 0; m < 4; ++m) for (int k = 0; k < 2; ++k) \
    dst[m][k] = *reinterpret_cast<const bf16x8*>(smem + a_base_ + (((b) * 2 + (h)) * 16384 + m * 2048 + k * 1024))
#define LDB(dst, b, h) for (int n = 0; n < 2; ++n) for (int k = 0; k < 2; ++k) \
    dst[n][k] = *reinterpret_cast<const bf16x8*>(smem + b_base_ + (((b) * 2 + (h)) * 16384 + n * 2048 + k * 1024))
#define MMA(ai, bj, At, Bt_) do { __builtin_amdgcn_s_setprio(1); \
    for (int m = 0; m < 4; ++m) for (int n = 0; n < 2; ++n) for (int k = 0; k < 2; ++k) \
      acc[ai][bj][m][n] = __builtin_amdgcn_mfma_f32_16x16x32_bf16(Bt_[n][k], At[m][k], acc[ai][bj][m][n], 0, 0, 0); \
    __builtin_amdgcn_s_setprio(0); } while (0)
#define WAIT_V(n) asm volatile("s_waitcnt vmcnt(" #n ")" ::: "memory")
#define WAIT_L(n) asm volatile("s_waitcnt lgkmcnt(" #n ")" ::: "memory")
#define BAR __builtin_amdgcn_s_barrier()
#define SCHED __builtin_amdgcn_sched_barrier(0)
  const int tid = fresh_tid();
  const int wid = tid >> 6, lane = tid & 63, wr = wid >> 2, wc = wid & 3, fr = lane & 15, fq = lane >> 4;
  const int tb16 = tid * 16;
  const unsigned a_base = (unsigned)lds_byte(wr * 64 + fr, fq * 8), b_base = 65536u + (unsigned)lds_byte(wc * 32 + fr, fq * 8);
  unsigned a_base_ = a_base, b_base_ = b_base; asm volatile("" : "+v"(a_base_), "+v"(b_base_));
  unsigned toff0, toff1;
  { int r0, c0, r1, c1; stage_rc(tb16, r0, c0); stage_rc(tb16 + 8192, r1, c1); toff0 = (unsigned)(r0 * K + c0); toff1 = (unsigned)(r1 * K + c1); }
  f32x4 acc[2][2][4][2] = {};
  bf16x8 At[4][2], B0[2][2], B1[2][2];
  const int nt = K / BK;
  STAGE(SB(0, 0), Bt, bcol, 0); STAGE(SA(0, 0), A, brow, 0);
  STAGE(SB(0, 1), Bt, bcol + HALF, 0); STAGE(SA(0, 1), A, brow + HALF, 0);
  if (wr == 1) BAR;
  WAIT_V(4); BAR;
  STAGE(SB(1, 0), Bt, bcol, 1); STAGE(SA(1, 0), A, brow, 1); STAGE(SB(1, 1), Bt, bcol + HALF, 1);
  WAIT_V(6); BAR;
  for (int t = 0; t < nt - 2; t += 2) {
    LDB(B0, 0, 0); SCHED; LDA(At, 0, 0); STAGE(SA(1, 1), A, brow + HALF, t + 1);
    WAIT_L(8); BAR; WAIT_L(0); MMA(0, 0, At, B0); BAR; SCHED;
    LDB(B1, 0, 1); STAGE(SB(0, 0), Bt, bcol, t + 2);
    BAR; WAIT_L(0); MMA(0, 1, At, B1); BAR;
    LDA(At, 0, 1); STAGE(SA(0, 0), A, brow, t + 2);
    BAR; WAIT_L(0); MMA(1, 0, At, B0); BAR; SCHED;
    STAGE(SB(0, 1), Bt, bcol + HALF, t + 2);
    WAIT_V(6); BAR; MMA(1, 1, At, B1); BAR;
    LDB(B0, 1, 0); SCHED; LDA(At, 1, 0); STAGE(SA(0, 1), A, brow + HALF, t + 2);
    WAIT_L(8); BAR; WAIT_L(0); MMA(0, 0, At, B0); BAR; SCHED;
    LDB(B1, 1, 1); STAGE(SB(1, 0), Bt, bcol, t + 3);
    BAR; WAIT_L(0); MMA(0, 1, At, B1); BAR;
    LDA(At, 1, 1); STAGE(SA(1, 0), A, brow, t + 3);
    BAR; WAIT_L(0); MMA(1, 0, At, B0); BAR; SCHED;
    STAGE(SB(1, 1), Bt, bcol + HALF, t + 3);
    WAIT_V(6); BAR; MMA(1, 1, At, B1); BAR;
  }
  { LDB(B0, 0, 0); LDA(At, 0, 0); STAGE(SA(1, 1), A, brow + HALF, nt - 1);
    BAR; WAIT_L(0); MMA(0, 0, At, B0); BAR;
    LDB(B1, 0, 1); BAR; WAIT_L(0); MMA(0, 1, At, B1); BAR;
    LDA(At, 0, 1); WAIT_V(4); BAR; WAIT_L(0); MMA(1, 0, At, B0); MMA(1, 1, At, B1); BAR; }
  { LDB(B0, 1, 0); LDA(At, 1, 0); WAIT_V(2); BAR; WAIT_L(0); MMA(0, 0, At, B0); BAR;
    LDB(B1, 1, 1); WAIT_V(0); BAR; WAIT_L(0); MMA(0, 1, At, B1); BAR;
    LDA(At, 1, 1); BAR; WAIT_L(0); MMA(1, 0, At, B0); MMA(1, 1, At, B1); BAR; }
  if (wr == 0) BAR;
  { int tid2 = threadIdx.x; asm volatile("" : "+v"(tid2));
    const int wid2 = tid2 >> 6, lane2 = tid2 & 63;
    epi(acc, brow, bcol, (wid2 >> 2) * 64, lane2 & 15, (wid2 & 3) * 32 + (lane2 >> 4) * 8, lane2); }
#undef SA
#undef SB
#undef STAGE
#undef LDA
#undef LDB
#undef MMA
}

DI bool tile_order(int i, int G, int c, int nM, int nN, int& pm, int& pn) {
  const int nwg = nM * nN; const long L = (long)i * G + c; if (L >= nwg) return false;
  int wgid = (int)L; { const int q = nwg / NXCD, r = nwg % NXCD, xcd = wgid % NXCD, off = wgid / NXCD; wgid = (xcd < r ? xcd * (q + 1) : r * (q + 1) + (xcd - r) * q) + off; }
  const int nig = WGM * nN, gid = wgid / nig, fm = gid * WGM, gsz = (nM - fm) < WGM ? (nM - fm) : WGM;
  pm = fm + ((wgid % nig) % gsz); pn = (wgid % nig) / gsz; return true;
}

struct EpiProj {
  bf16_t* O; bf16_t* gvT; bf16_t* dvT; int vmode;
  DI void operator()(f32x4 (&acc)[2][2][4][2], int brow, int bcol, int rw, int fr, int cw, int lane) const {
    const int rperm = 8 * (fr >> 2) + (fr & 3);
    if (vmode == 0) {
      const bool sil = (bcol >= C_GZ && bcol < C_DQ) || (bcol >= C_DZ);
#pragma unroll
      for (int ai = 0; ai < 2; ++ai)
#pragma unroll
        for (int m = 0; m < 4; ++m) {
          const int row = brow + ai * HALF + rw + (m >> 1) * 32 + 4 * (m & 1) + rperm;
          bf16_t* rp = O + (size_t)row * NP + bcol + cw;
#pragma unroll
          for (int bj = 0; bj < 2; ++bj) {
            f32x4 v0 = acc[ai][bj][m][0], v1 = acc[ai][bj][m][1];
            if (sil) {
#pragma unroll
              for (int j = 0; j < 4; ++j) { v0[j] = silu_f(v0[j]); v1[j] = silu_f(v1[j]); }
            }
            u32x4 w; w.x = pk_bf16(v0[0], v0[1]); w.y = pk_bf16(v0[2], v0[3]); w.z = pk_bf16(v1[0], v1[1]); w.w = pk_bf16(v1[2], v1[3]);
            *(u32x4*)(rp + bj * HALF) = w;
          }
        }
    } else {
      bf16_t* T = (vmode == 1) ? gvT : dvT;
      const int vbase = brow - ((vmode == 1) ? C_GV : C_DV);
      const int b = bcol / SEQ, s0 = bcol % SEQ + cw;
#pragma unroll
      for (int ai = 0; ai < 2; ++ai)
#pragma unroll
        for (int m = 0; m < 4; ++m) {
          const int v = vbase + ai * HALF + rw + (m >> 1) * 32 + 4 * (m & 1) + rperm;
          bf16_t* rp = T + ((size_t)b * 512 + v) * SEQ + s0;
#pragma unroll
          for (int bj = 0; bj < 2; ++bj) {
            const f32x4 v0 = acc[ai][bj][m][0], v1 = acc[ai][bj][m][1];
            u32x4 w; w.x = pk_bf16(v0[0], v0[1]); w.y = pk_bf16(v0[2], v0[3]); w.z = pk_bf16(v1[0], v1[1]); w.w = pk_bf16(v1[2], v1[3]);
            *(u32x4*)(rp + bj * HALF) = w;
          }
        }
    }
  }
};
struct EpiOut {
  const float* x; const float* mod; const float* fgain; float* out; float* rowsq; unsigned* pcnt;
  DI void operator()(f32x4 (&acc)[2][2][4][2], int brow, int bcol, int rw, int fr, int cwp, int lane) const {
    extern __shared__ __attribute__((aligned(16))) unsigned char smem[];
    constexpr int TS = 1040;
    const int b = brow / SEQ, wid = threadIdx.x >> 6;
    const int cw = (cwp & ~31) + ((cwp & 31) >> 1);
    f32x4 gt[2][2];
#pragma unroll
    for (int bj = 0; bj < 2; ++bj)
#pragma unroll
      for (int n = 0; n < 2; ++n) gt[bj][n] = *(const f32x4*)(mod + (size_t)b * 3072 + 2048 + bcol + cw + bj * HALF + n * 16);
    f32x4 Y[2][16];
    float myss[2] = {0.f, 0.f};
    __syncthreads();
#pragma unroll
    for (int ai = 0; ai < 2; ++ai) {
      const float* xb = x + (size_t)(brow + ai * HALF + wid * 16) * 1024 + bcol + lane * 4;
#pragma unroll
      for (int i = 0; i < 16; ++i) Y[ai][i] = __builtin_nontemporal_load((const f32x4*)(xb + (size_t)i * 1024));
#pragma unroll
      for (int m = 0; m < 4; ++m)
#pragma unroll
        for (int bj = 0; bj < 2; ++bj)
#pragma unroll
          for (int n = 0; n < 2; ++n)
            *(f32x4*)(smem + (rw + m * 16 + fr) * TS + (bj * HALF + cw + n * 16) * 4) = gt[bj][n] * acc[ai][bj][m][n];
      __syncthreads();
#pragma unroll
      for (int i = 0; i < 16; ++i) {
        const f32x4 v = *(const f32x4*)(smem + (wid * 16 + i) * TS + lane * 16);
        const f32x4 y = Y[ai][i] + v; Y[ai][i] = y;
        const float ss = wave_sum(y[0] * y[0] + y[1] * y[1] + y[2] * y[2] + y[3] * y[3]);
        if (lane == i) myss[ai] = ss;
      }
      __syncthreads();
    }
    if (lane < 16) {
      (void)__hip_atomic_fetch_add(rowsq + (size_t)(brow + wid * 16 + lane), myss[0], __ATOMIC_RELAXED, __HIP_MEMORY_SCOPE_AGENT);
      (void)__hip_atomic_fetch_add(rowsq + (size_t)(brow + HALF + wid * 16 + lane), myss[1], __ATOMIC_RELAXED, __HIP_MEMORY_SCOPE_AGENT);
    }
    asm volatile("s_waitcnt vmcnt(0)" ::: "memory");
    __syncthreads();
    if (threadIdx.x == 0) {
      unsigned* c = pcnt + (brow >> 8);
      (void)__hip_atomic_fetch_add(c, 1u, __ATOMIC_RELAXED, __HIP_MEMORY_SCOPE_AGENT);
      unsigned sp = 0;
      while (__hip_atomic_load(c, __ATOMIC_RELAXED, __HIP_MEMORY_SCOPE_AGENT) < 4u) { __builtin_amdgcn_s_sleep(1); if (++sp > (1u << 22)) break; }
    }
    __syncthreads();
    float rn[2] = {0.f, 0.f};
    if (lane < 16) {
      rn[0] = rsqrtf(__hip_atomic_load(rowsq + (size_t)(brow + wid * 16 + lane), __ATOMIC_RELAXED, __HIP_MEMORY_SCOPE_AGENT) * (1.f / 1024.f) + EPS);
      rn[1] = rsqrtf(__hip_atomic_load(rowsq + (size_t)(brow + HALF + wid * 16 + lane), __ATOMIC_RELAXED, __HIP_MEMORY_SCOPE_AGENT) * (1.f / 1024.f) + EPS);
    }
    const f32x4 fg = *(const f32x4*)(fgain + bcol + lane * 4);
#pragma unroll
    for (int ai = 0; ai < 2; ++ai) {
      float* ob = out + (size_t)(brow + ai * HALF + wid * 16) * 1024 + bcol + lane * 4;
#pragma unroll
      for (int i = 0; i < 16; ++i) __builtin_nontemporal_store(Y[ai][i] * __shfl(rn[ai], i) * fg, (f32x4*)(ob + (size_t)i * 1024));
    }
  }
};

DI void gemm1_phase(const Params& p) {
  for (int i = 0;; ++i) {
    int pm, pn; if (!tile_order(i, gridDim.x, blockIdx.x, NTOK / BM, NP / BM, pm, pn)) break;
    const int vmode = (pn == 2 || pn == 3) ? 1 : ((pn == 10 || pn == 11) ? 2 : 0);
    const bf16_t* A = vmode ? p.winT : p.h; const bf16_t* Bt = vmode ? p.h : p.winT;
    const int brow = vmode ? pn * BM : pm * BM, bcol = vmode ? pm * BM : pn * BM;
    gemm_tile(A, Bt, 1024, brow, bcol, EpiProj{p.proj, p.gvT, p.dvT, vmode});
  }
}
DI void gemm2_phase(const Params& p) {
  for (int i = 0;; ++i) {
    int pm, pn; if (!tile_order(i, gridDim.x, blockIdx.x, NTOK / BM, 1024 / BM, pm, pn)) break;
    gemm_tile(p.mix, p.woutT, 1024, pm * BM, pn * BM, EpiOut{p.x, p.mod, p.final_gain, p.out, p.rowsq, p.pcnt});
  }
}

DI float lam_value(const Params& p, const int t) {
  const int i = t & 63;
  const float s1 = wave_sum(p.lq1[i] * p.lk1[i]), s2 = wave_sum(p.lq2[i] * p.lk2[i]);
  return __expf(s1) - __expf(s2) + 0.2f;
}

#define LBAR() do { asm volatile("s_waitcnt lgkmcnt(0)" ::: "memory"); __builtin_amdgcn_s_barrier(); asm volatile("" ::: "memory"); } while (0)

typedef float f32x16 __attribute__((ext_vector_type(16)));
#define MFMA32(a, b, c) __builtin_amdgcn_mfma_f32_32x32x16_bf16((a), (b), (c), 0, 0, 0)
constexpr int AT_KB = 16384, AT_VB = 16384, AT_BUF = AT_KB + AT_VB;

DI bf16x8 pack8(const f32x16& x, int s) {
  u32x4 p; p.x = pk_bf16(x[8 * s], x[8 * s + 1]); p.y = pk_bf16(x[8 * s + 2], x[8 * s + 3]); p.z = pk_bf16(x[8 * s + 4], x[8 * s + 5]); p.w = pk_bf16(x[8 * s + 6], x[8 * s + 7]);
  return __builtin_bit_cast(bf16x8, p);
}
DI int swap23(int x) { return (x & ~12) | ((x & 4) << 1) | ((x & 8) >> 1); }

constexpr int AT_K0 = 0, AT_V0 = 49152;
DI void attn_item(const Params& p, const int bh, const int qb, const float lam, unsigned char* smem, const int t) {
  const int lane = t & 63, wid = t >> 6, r32 = lane & 31, hl = lane >> 5;
  const int qg = wid & 3, mp = wid >> 2;
  const int b = bh >> 2, hd = bh & 3;
  const size_t tokb = (size_t)b * SEQ;
  const int q0 = qb * 128 + qg * 32, iq = q0 + r32;
  const float slope2 = exp2f(-2.f * (hd + 1)) * 1.44269504f;
  const f32x2 c1v = {0.125f * 1.44269504f, 0.125f * 1.44269504f};
  bf16x8 qf[4];
  {
    const bf16_t* qp = p.proj + (tokb + iq) * NP + C_DQ + hd * 128 + mp * 64 + hl * 8;
#pragma unroll
    for (int sl = 0; sl < 4; ++sl) qf[sl] = *(const bf16x8*)(qp + sl * 16);
  }
  f32x2 kb[8];
#pragma unroll
  for (int i = 0; i < 8; ++i) { const int kof = 16 * ((2 * i) >> 3) + ((2 * i) & 7) + 8 * hl; kb[i] = (f32x2){slope2 * (float)kof, slope2 * (float)(kof + 1)}; }
  f32x16 O[4];
#pragma unroll
  for (int dt = 0; dt < 4; ++dt)
#pragma unroll
    for (int r = 0; r < 16; ++r) O[dt][r] = 0.f;
  float mrun = 0.f, lrun = 0.f;
  const int L0 = wid * 128 + lane, L1 = L0 + 64;
  const int kr0 = L0 >> 4, kr1 = L1 >> 4;
  const bf16_t* kg0 = p.proj + (tokb + kr0) * NP + C_DK + hd * 128 + (((L0 & 15) ^ (kr0 & 15)) << 3);
  const bf16_t* kg1 = p.proj + (tokb + kr1) * NP + C_DK + hd * 128 + (((L1 & 15) ^ (kr1 & 15)) << 3);
  const int vr0 = L0 >> 3, vr1 = L1 >> 3;
  const bf16_t* vg0 = p.dvT + ((size_t)bh * 128 + vr0) * SEQ + (((L0 & 7) ^ ((vr0 >> 1) & 7)) << 3);
  const bf16_t* vg1 = p.dvT + ((size_t)bh * 128 + vr1) * SEQ + (((L1 & 7) ^ ((vr1 >> 1) & 7)) << 3);
  const unsigned wslot = wid * 2048;
#define AT_STAGE(kbo, vbo, jt_) do { \
    __builtin_amdgcn_global_load_lds((const unsigned*)(kg0 + (size_t)(jt_) * 64 * NP), (unsigned*)(smem + (kbo) + wslot), 16, 0, 0); \
    __builtin_amdgcn_global_load_lds((const unsigned*)(kg1 + (size_t)(jt_) * 64 * NP), (unsigned*)(smem + (kbo) + wslot + 1024), 16, 0, 0); \
    __builtin_amdgcn_global_load_lds((const unsigned*)(vg0 + (jt_) * 64), (unsigned*)(smem + (vbo) + wslot), 16, 0, 0); \
    __builtin_amdgcn_global_load_lds((const unsigned*)(vg1 + (jt_) * 64), (unsigned*)(smem + (vbo) + wslot + 1024), 16, 0, 0); } while (0)
  const int krow = swap23(r32);
  const unsigned kread = (krow * 256) | ((((krow & 15) ^ hl) << 4) ^ (mp << 7));
  const unsigned vread = r32 * 128 + ((hl ^ ((r32 >> 1) & 7)) << 4);
  const int nt = 2 * qb + 2, wnt = 2 * qb + (qg >> 1) + 1;
#define AT_QK(kbuf_) do { \
    bf16x8 kq0[4], kq1[4]; \
    _Pragma("unroll") for (int sl = 0; sl < 4; ++sl) { \
      kq0[sl] = *(const bf16x8*)((kbuf_) + (kread ^ (unsigned)((sl * 2) << 4))); \
      kq1[sl] = *(const bf16x8*)((kbuf_) + 8192 + (kread ^ (unsigned)((sl * 2) << 4))); } \
    _Pragma("unroll") for (int r = 0; r < 16; ++r) { S0[r] = 0.f; S1[r] = 0.f; } \
    __builtin_amdgcn_sched_barrier(0); \
    _Pragma("unroll") for (int sl = 0; sl < 4; ++sl) { S0 = MFMA32(kq0[sl], qf[sl], S0); S1 = MFMA32(kq1[sl], qf[sl], S1); } } while (0)
#define AT_SOFTMAX(DIAG) do { \
    const int dj = jt * 64 + 8 * hl - iq; \
    const float dls = slope2 * (float)(jt * 64 - iq) - mrun; \
    const f32x2 dl0 = {dls, dls}, dl1 = {dls + slope2 * 32.f, dls + slope2 * 32.f}; \
    float mx = -1e30f; \
    _Pragma("unroll") for (int i = 0; i < 8; ++i) { \
      const int kof = 16 * ((2 * i) >> 3) + ((2 * i) & 7); \
      f32x2 u0 = (f32x2){S0[2 * i], S0[2 * i + 1]} * c1v + (kb[i] + dl0), u1 = (f32x2){S1[2 * i], S1[2 * i + 1]} * c1v + (kb[i] + dl1); \
      if (DIAG) { if (dj + kof > 0) u0.x = -1e30f; if (dj + kof + 1 > 0) u0.y = -1e30f; if (dj + 32 + kof > 0) u1.x = -1e30f; if (dj + 33 + kof > 0) u1.y = -1e30f; } \
      S0[2 * i] = u0.x; S0[2 * i + 1] = u0.y; S1[2 * i] = u1.x; S1[2 * i + 1] = u1.y; \
      mx = fmaxf(fmaxf(mx, u0.x), fmaxf(u0.y, fmaxf(u1.x, u1.y))); } \
    mx = fmaxf(mx, __shfl_xor(mx, 32)); \
    live = first || !__all(mx < -60.f);     \
    if (!live) break; \
    if (__any(mx > 8.f) || first) { \
      const float inc = first ? mx : fmaxf(mx, 0.f), al = first ? 0.f : __builtin_amdgcn_exp2f(-inc);     \
      mrun += inc; lrun *= al; \
      _Pragma("unroll") for (int dt = 0; dt < 4; ++dt) _Pragma("unroll") for (int r = 0; r < 16; ++r) O[dt][r] *= al; \
      _Pragma("unroll") for (int r = 0; r < 16; ++r) { S0[r] -= inc; S1[r] -= inc; } } \
    f32x2 ls2 = {0.f, 0.f}; \
    _Pragma("unroll") for (int i = 0; i < 8; ++i) { \
      const f32x2 p0 = {__builtin_amdgcn_exp2f(S0[2 * i]), __builtin_amdgcn_exp2f(S0[2 * i + 1])}, p1 = {__builtin_amdgcn_exp2f(S1[2 * i]), __builtin_amdgcn_exp2f(S1[2 * i + 1])}; \
      S0[2 * i] = p0.x; S0[2 * i + 1] = p0.y; S1[2 * i] = p1.x; S1[2 * i + 1] = p1.y; ls2 += p0 + p1; } \
    lrun += ls2.x + ls2.y; \
    pf[0] = pack8(S0, 0); pf[1] = pack8(S0, 1); pf[2] = pack8(S1, 0); pf[3] = pack8(S1, 1); } while (0)
#define AT_VLD(dst, vbuf_, ks) _Pragma("unroll") for (int dt = 0; dt < 4; ++dt) dst[dt] = *(const bf16x8*)((vbuf_) + dt * 4096 + (vread ^ (unsigned)((ks) << 5)))
#define AT_VMM(src, ks) _Pragma("unroll") for (int dt = 0; dt < 4; ++dt) O[dt] = MFMA32(src[dt], pf[ks], O[dt])
#define AT_PV(vbuf_) do { \
    bf16x8 va[4], vb[4]; \
    AT_VLD(va, vbuf_, 0); AT_VLD(vb, vbuf_, 1); \
    __builtin_amdgcn_sched_barrier(0); \
    __builtin_amdgcn_s_setprio(1); \
    AT_VMM(va, 0); AT_VLD(va, vbuf_, 2); \
    __builtin_amdgcn_sched_barrier(0); \
    AT_VMM(vb, 1); AT_VLD(vb, vbuf_, 3); \
    __builtin_amdgcn_sched_barrier(0); \
    AT_VMM(va, 2); AT_VMM(vb, 3); \
    __builtin_amdgcn_s_setprio(0); } while (0)
  f32x16 S0, S1;
  bf16x8 pf[4];
  int kcur = 0;
  bool live = false, pend = false;
  __syncthreads();
  AT_STAGE(AT_K0, AT_V0, nt - 1);
  AT_STAGE(AT_K0 + 16384, AT_V0 + 16384, nt - 2);
  asm volatile("s_waitcnt vmcnt(4)" ::: "memory");
  LBAR();
  for (int it = 0; it < nt; ++it) {
    const int jt = nt - 1 - it;
    const bool first = (jt == wnt - 1);
    unsigned char* kbuf = smem + AT_K0 + kcur * 16384;
    unsigned char* vbuf = smem + AT_V0 + (it & 3) * 16384;
    const int k2 = (kcur == 0) ? 2 : kcur - 1;
    if (it + 2 < nt) AT_STAGE(AT_K0 + k2 * 16384, AT_V0 + ((it + 2) & 3) * 16384, jt - 2);
    if (mp == 0) {
      if (jt < wnt) {
        AT_QK(kbuf);
        if (jt * 64 + 63 > q0) AT_SOFTMAX(1); else AT_SOFTMAX(0);
        if (live) AT_PV(vbuf);
      }
    } else {
      if (jt < wnt) AT_QK(kbuf);
      if (pend) AT_PV(smem + AT_V0 + ((it - 1) & 3) * 16384);
      pend = false;
      if (jt < wnt) { if (jt * 64 + 63 > q0) AT_SOFTMAX(1); else AT_SOFTMAX(0); pend = live; }
    }
    kcur = (kcur == 2) ? 0 : kcur + 1;
    if (it + 2 < nt) asm volatile("s_waitcnt vmcnt(4)" ::: "memory"); else asm volatile("s_waitcnt vmcnt(0)" ::: "memory");
    LBAR();
  }
  if (mp == 1 && pend) AT_PV(smem + AT_V0 + ((nt - 1) & 3) * 16384);
  __syncthreads();
#undef AT_STAGE
#undef AT_QK
#undef AT_SOFTMAX
#undef AT_PV
#undef AT_VLD
#undef AT_VMM
  const float lt = lrun + __shfl_xor(lrun, 32);
  const float sc = (mp ? lam : 1.f) / lt;
  float* xch = (float*)(smem + qg * 16384);
  if (mp == 1) {
#pragma unroll
    for (int dt = 0; dt < 4; ++dt)
#pragma unroll
      for (int g = 0; g < 4; ++g)
        *(f32x4*)(xch + ((dt * 4 + g) * 64 + lane) * 4) = (f32x4){O[dt][4 * g] * sc, O[dt][4 * g + 1] * sc, O[dt][4 * g + 2] * sc, O[dt][4 * g + 3] * sc};
  }
  __syncthreads();
  if (mp == 0) {
    float ss = 0.f;
#pragma unroll
    for (int dt = 0; dt < 4; ++dt)
#pragma unroll
      for (int g = 0; g < 4; ++g) {
        const f32x4 o2 = *(const f32x4*)(xch + ((dt * 4 + g) * 64 + lane) * 4);
#pragma unroll
        for (int j = 0; j < 4; ++j) { const float o = O[dt][4 * g + j] * sc - o2[j]; O[dt][4 * g + j] = o; ss += o * o; }
      }
    ss += __shfl_xor(ss, 32);
    const float rn = rsqrtf(ss * (1.f / 128.f) + EPS) * 0.8f;
    const bf16_t* zp = p.proj + (tokb + iq) * NP + C_DZ + hd * 128 + 4 * hl;
    bf16_t* mo = p.mix + (tokb + iq) * 1024 + 512 + hd * 128 + 4 * hl;
    const float* gp = p.diff_gain + hd * 128 + 4 * hl;
#pragma unroll
    for (int dt = 0; dt < 4; ++dt)
#pragma unroll
      for (int g = 0; g < 4; ++g) {
        const int dv = dt * 32 + 8 * g;
        const u32x2 zz = *(const u32x2*)(zp + dv); const f32x4 gn = *(const f32x4*)(gp + dv);
        const float y0 = O[dt][4 * g + 0] * rn * gn[0] * bf_lo(zz.x), y1 = O[dt][4 * g + 1] * rn * gn[1] * bf_hi(zz.x);
        const float y2 = O[dt][4 * g + 2] * rn * gn[2] * bf_lo(zz.y), y3 = O[dt][4 * g + 3] * rn * gn[3] * bf_hi(zz.y);
        u32x2 w; w.x = pk_bf16(y0, y1); w.y = pk_bf16(y2, y3);
        *(u32x2*)(mo + dv) = w;
      }
  }
}

constexpr int GL_QIN = 0, GL_KIN = 8192, GL_KST = 16384, GL_DEC = 24576, GL_CS = 24832, GL_XST = 26880, GL_OSQ = 43264, GL_PF = 44288;
constexpr int GP_VT = 0, GP_Q = 16384, GP_K = 24576, GP_LA = 32768, GP_SZ = 49152;
DI unsigned sw128(int row, int chunk) { return (unsigned)(row * 128 + ((chunk ^ ((row >> 1) & 7)) << 4)); }

DI void gla_item(const Params& p, const int bh, unsigned char* smem, const int t) {
  const int lane = t & 63, wid = t >> 6, r32 = lane & 31, hl = lane >> 5;
  const int vt = wid & 3, kt = wid >> 2, it = kt;
  const int b = bh >> 2, hd = bh & 3;
  const size_t tokb = (size_t)b * SEQ;
  const int d = lane, jg = wid, col = hd * 64 + d;
  f32x16 St;
#pragma unroll
  for (int r = 0; r < 16; ++r) St[r] = 0.f;
  const int L0 = wid * 128 + lane, L1 = L0 + 64, vr0 = L0 >> 3, vr1 = L1 >> 3;
  const bf16_t* vg0 = p.gvT + ((size_t)bh * 128 + vr0) * SEQ + (((L0 & 7) ^ ((vr0 >> 1) & 7)) << 3);
  const bf16_t* vg1 = p.gvT + ((size_t)bh * 128 + vr1) * SEQ + (((L1 & 7) ^ ((vr1 >> 1) & 7)) << 3);
  const int Lq = wid * 64 + lane;
  const bf16_t* qg = p.proj + (tokb + (Lq >> 3)) * NP + C_GQ + hd * 64 + (Lq & 7) * 8;
  const bf16_t* kg = p.proj + (tokb + (Lq >> 3)) * NP + C_GK + hd * 64 + (Lq & 7) * 8;
  const int La0 = wid * 128 + lane, La1 = La0 + 64;
  const float* lag0 = p.la + (tokb + (La0 >> 4)) * 256 + hd * 64 + (La0 & 15) * 4;
  const float* lag1 = p.la + (tokb + (La1 >> 4)) * 256 + hd * 64 + (La1 & 15) * 4;
#define GL_STAGE(bufo, ch_) do { \
    __builtin_amdgcn_global_load_lds((const unsigned*)(vg0 + (ch_) * 64), (unsigned*)(smem + (bufo) + GP_VT + wid * 2048), 16, 0, 0); \
    __builtin_amdgcn_global_load_lds((const unsigned*)(vg1 + (ch_) * 64), (unsigned*)(smem + (bufo) + GP_VT + wid * 2048 + 1024), 16, 0, 0); \
    __builtin_amdgcn_global_load_lds((const unsigned*)(qg + (size_t)(ch_) * 64 * NP), (unsigned*)(smem + (bufo) + GP_Q + wid * 1024), 16, 0, 0); \
    __builtin_amdgcn_global_load_lds((const unsigned*)(kg + (size_t)(ch_) * 64 * NP), (unsigned*)(smem + (bufo) + GP_K + wid * 1024), 16, 0, 0); \
    __builtin_amdgcn_global_load_lds((const unsigned*)(lag0 + (size_t)(ch_) * 64 * 256), (unsigned*)(smem + (bufo) + GP_LA + wid * 2048), 16, 0, 0); \
    __builtin_amdgcn_global_load_lds((const unsigned*)(lag1 + (size_t)(ch_) * 64 * 256), (unsigned*)(smem + (bufo) + GP_LA + wid * 2048 + 1024), 16, 0, 0); } while (0)
  const int krow = swap23(r32);
  const int qi = it * 32 + r32;
  float* cs = (float*)(smem + GL_CS); float* dec = (float*)(smem + GL_DEC); float* osq = (float*)(smem + GL_OSQ);
  const int v0 = hd * 128 + vt * 32 + 4 * hl;
  f32x4 gnv[4];
#pragma unroll
  for (int g = 0; g < 4; ++g) gnv[g] = *(const f32x4*)(p.gla_gain + v0 + 8 * g);
  __syncthreads();
  GL_STAGE(GL_PF, 0);
  asm volatile("s_waitcnt vmcnt(0)" ::: "memory");
  __syncthreads();
  for (int ch = 0; ch < SEQ / 64; ++ch) {
    const size_t tok0 = tokb + (size_t)ch * 64;
    unsigned char* pb = smem + GL_PF + (ch & 1) * GP_SZ;
    if (ch + 1 < SEQ / 64) GL_STAGE(GL_PF + ((ch + 1) & 1) * GP_SZ, ch + 1);
    const bf16_t* zp = p.proj + (tok0 + qi) * NP + C_GZ + v0;
    u32x2 zz[4];
#pragma unroll
    for (int g = 0; g < 4; ++g) zz[g] = *(const u32x2*)(zp + 8 * g);
    float la[8], qv[8], kv[8];
    {
      float run = 0.f;
#pragma unroll
      for (int e = 0; e < 8; ++e) {
        const int j = jg * 8 + e;
        run += *(const float*)(pb + GP_LA + j * 256 + d * 4); la[e] = run;
        qv[e] = bf2f(*(const bf16_t*)(pb + GP_Q + j * 128 + d * 2)); kv[e] = bf2f(*(const bf16_t*)(pb + GP_K + j * 128 + d * 2));
      }
      cs[jg * 64 + d] = run;
    }
    LBAR();
    {
      float pre = 0.f, tot = 0.f;
#pragma unroll
      for (int g = 0; g < 8; ++g) { const float c = cs[g * 64 + d]; tot += c; if (g < jg) pre += c; }
      const float etot = __builtin_amdgcn_exp2f(tot * 1.44269504f);
      float ks[8];
#pragma unroll
      for (int e = 0; e < 8; ++e) {
        const int j = jg * 8 + e; const float bc = pre + la[e];
        const float eb = __builtin_amdgcn_exp2f(bc * 1.44269504f), ib = __builtin_amdgcn_rcpf(eb);
        const float qin = qv[e] * 0.125f * eb, kin = kv[e] * ib;
        ks[e] = kin * etot;
        const unsigned off = sw128(j, d >> 3) + ((d & 7) << 1);
        *(bf16_t*)(smem + GL_QIN + off) = (bf16_t)(pk_bf16(qin, 0.f) & 0xffff);
        *(bf16_t*)(smem + GL_KIN + off) = (bf16_t)(pk_bf16(kin, 0.f) & 0xffff);
      }
      u32x4 w; w.x = pk_bf16(ks[0], ks[1]); w.y = pk_bf16(ks[2], ks[3]); w.z = pk_bf16(ks[4], ks[5]); w.w = pk_bf16(ks[6], ks[7]);
      *(u32x4*)(smem + GL_KST + sw128(d, jg)) = w;
      if (jg == 0) dec[d] = etot;
      *(bf16x8*)(smem + GL_XST + ((wid * 2 + 0) * 64 + lane) * 16) = pack8(St, 0);
      *(bf16x8*)(smem + GL_XST + ((wid * 2 + 1) * 64 + lane) * 16) = pack8(St, 1);
    }
    LBAR();
    f32x16 Oacc;
#pragma unroll
    for (int r = 0; r < 16; ++r) Oacc[r] = 0.f;
#pragma unroll
    for (int js = 0; js < 2; ++js) {
      if (js > it) continue;
      f32x16 S;
#pragma unroll
      for (int r = 0; r < 16; ++r) S[r] = 0.f;
#pragma unroll
      for (int sl = 0; sl < 4; ++sl) {
        const bf16x8 af = *(const bf16x8*)(smem + GL_KIN + sw128(js * 32 + krow, sl * 2 + hl));
        const bf16x8 bq = *(const bf16x8*)(smem + GL_QIN + sw128(qi, sl * 2 + hl));
        S = MFMA32(af, bq, S);
      }
      if (js == it) {
#pragma unroll
        for (int r = 0; r < 16; ++r) { const int kof = 16 * (r >> 3) + (r & 7) + 8 * hl; if (kof > r32) S[r] = 0.f; }
      }
      const bf16x8 pf0 = pack8(S, 0), pf1 = pack8(S, 1);
      const bf16x8 va = *(const bf16x8*)(pb + GP_VT + sw128(vt * 32 + r32, js * 4 + 0 + hl));
      const bf16x8 vb = *(const bf16x8*)(pb + GP_VT + sw128(vt * 32 + r32, js * 4 + 2 + hl));
      Oacc = MFMA32(va, pf0, Oacc); Oacc = MFMA32(vb, pf1, Oacc);
    }
#pragma unroll
    for (int kk = 0; kk < 2; ++kk)
#pragma unroll
      for (int s2 = 0; s2 < 2; ++s2) {
        const bf16x8 sf = *(const bf16x8*)(smem + GL_XST + (((kk * 4 + vt) * 2 + s2) * 64 + lane) * 16);
        const bf16x8 bq = *(const bf16x8*)(smem + GL_QIN + sw128(qi, kk * 4 + s2 * 2 + hl));
        Oacc = MFMA32(sf, bq, Oacc);
      }
    {
      const float* dp = dec + kt * 32 + 8 * hl;
      const f32x4 d0 = *(const f32x4*)(dp), d1 = *(const f32x4*)(dp + 4), d2 = *(const f32x4*)(dp + 16), d3 = *(const f32x4*)(dp + 20);
#pragma unroll
      for (int j = 0; j < 4; ++j) { St[j] *= d0[j]; St[4 + j] *= d1[j]; St[8 + j] *= d2[j]; St[12 + j] *= d3[j]; }
#pragma unroll
      for (int ks = 0; ks < 4; ++ks) {
        const bf16x8 af = *(const bf16x8*)(smem + GL_KST + sw128(kt * 32 + krow, ks * 2 + hl));
        const bf16x8 bv = *(const bf16x8*)(pb + GP_VT + sw128(vt * 32 + r32, ks * 2 + hl));
        St = MFMA32(af, bv, St);
      }
    }
    {
      float ss = 0.f;
#pragma unroll
      for (int r = 0; r < 16; ++r) ss += Oacc[r] * Oacc[r];
      ss += __shfl_xor(ss, 32);
      if (hl == 0) osq[vt * 64 + qi] = ss;
    }
    asm volatile("s_waitcnt vmcnt(0)" ::: "memory");
    LBAR();
    {
      const float tot = osq[qi] + osq[64 + qi] + osq[128 + qi] + osq[192 + qi];
      const float rn = rsqrtf(tot * (1.f / 128.f) + EPS);
      bf16_t* mo = p.mix + (tok0 + qi) * 1024 + v0;
#pragma unroll
      for (int g = 0; g < 4; ++g) {
        const f32x4 gn = gnv[g];
        const float y0 = Oacc[4 * g + 0] * rn * gn[0] * bf_lo(zz[g].x), y1 = Oacc[4 * g + 1] * rn * gn[1] * bf_hi(zz[g].x);
        const float y2 = Oacc[4 * g + 2] * rn * gn[2] * bf_lo(zz[g].y), y3 = Oacc[4 * g + 3] * rn * gn[3] * bf_hi(zz[g].y);
        u32x2 w; w.x = pk_bf16(y0, y1); w.y = pk_bf16(y2, y3);
        *(u32x2*)(mo + 8 * g) = w;
      }
    }
  }
#undef GL_STAGE
}

DI void mixer_phase(const Params& p, unsigned char* smem, const int t, const int cidx = 0, const int first = 0, const int limit = 100000) {
  const float lam = lam_value(p, t);
  constexpr int N_GLA = 64, N_ATT = 64 * 16;
  volatile int* sitem = (volatile int*)(smem + LDS_BYTES - 16);
  for (;;) {
    __syncthreads();
    if (t == 0) *sitem = first + (int)atomicAdd(p.ctr + cidx, 1u);
    __syncthreads();
    const int item = *sitem;
    if (item >= N_GLA + N_ATT || item >= limit) break;
#ifndef NO_GLA
    if (item < N_GLA) gla_item(p, item, smem, fresh_tid());
#endif
#ifndef NO_ATT
    if (item >= N_GLA) { const int a = item - N_GLA; attn_item(p, a & 63, 15 - (a >> 6), lam, smem, fresh_tid()); }
#endif
  }
}

DI void final_phase(const Params& p, const int t) {
  const size_t n4 = (size_t)NTOK * 1024 / 4;
  for (size_t i = (size_t)blockIdx.x * NTHREADS + t; i < n4; i += (size_t)gridDim.x * NTHREADS) {
    const size_t row = i >> 8; const int c4 = (int)(i & 255) * 4;
    const float r = rsqrtf(p.rowsq[row] * (1.f / 1024.f) + EPS);
    const f32x4 y = *(const f32x4*)(p.out + i * 4), gv = *(const f32x4*)(p.final_gain + c4);
    *(f32x4*)(p.out + i * 4) = y * r * gv;
  }
}

typedef const __attribute__((address_space(4))) Params* ParamsK;
DI Params fresh_params() {
#if defined(__HIP_DEVICE_COMPILE__)
  ParamsK kp = (ParamsK)__builtin_amdgcn_kernarg_segment_ptr(); asm volatile("" : "+s"(kp));
  Params r; __builtin_memcpy_inline(&r, kp, sizeof(Params)); return r;
#else
  return Params{};
#endif
}

__global__ void __launch_bounds__(NTHREADS, 2) fwd_kernel(Params p_) {
  extern __shared__ __attribute__((aligned(16))) unsigned char smem[];
  cg::grid_group grid = cg::this_grid();
  const int lo = p_.phase_lo, hi = p_.phase_hi;
  if (hi == 99) grid.sync();
  volatile LAS unsigned* st = (volatile LAS unsigned*)(smem + LDS_BYTES - 32);
  if (lo < hi) {
    if (threadIdx.x == 0) { st[0] = 0u; st[1] = 0u; (void)xb_add(&p_.bar[XB_XCNT(xb_xcc_id())], 1u); }
    __syncthreads();
  }
#define SEAM(a_) do { if (lo <= (a_) && (a_) + 1 <= hi) { const Params pb = fresh_params(); xcd_barrier(pb.bar, st); } } while (0)
#ifndef PHM
#define PHM 63
#endif
  if ((PHM & 1) && lo <= 0 && 0 <= hi) { const Params p = fresh_params(); phase0a(p, smem, fresh_tid()); }
  SEAM(0);
  if ((PHM & 2) && lo <= 1 && 1 <= hi) { const Params p = fresh_params(); phase0b(p, smem, fresh_tid()); }
  SEAM(1);
  if ((PHM & 4) && lo <= 2 && 2 <= hi) { const Params p = fresh_params(); gemm1_phase(p); }
  SEAM(2);
  if ((PHM & 8) && lo <= 3 && 3 <= hi) { const Params p = fresh_params(); mixer_phase(p, smem, fresh_tid()); }
  SEAM(3);
  if ((PHM & 16) && lo <= 4 && 4 <= hi) { const Params p = fresh_params(); gemm2_phase(p); }
}

extern "C" void kernel_launch(void* const* d_in, const int* in_sizes, int n_in, void* d_out, int out_size, void* d_ws, size_t ws_size, hipStream_t stream) {
  static int grid_blocks = 0;
  if (!grid_blocks) {
    hipFuncSetAttribute((const void*)fwd_kernel, hipFuncAttributeMaxDynamicSharedMemorySize, LDS_BYTES);
    int dev = 0, cus = 0, per_cu = 0;
    hipGetDevice(&dev);
    hipDeviceGetAttribute(&cus, hipDeviceAttributeMultiprocessorCount, dev);
    hipOccupancyMaxActiveBlocksPerMultiprocessor(&per_cu, fwd_kernel, NTHREADS, LDS_BYTES);
    if (per_cu < 1) per_cu = 1;
    grid_blocks = cus * per_cu;
  }
  Params p{};
  p.x = (const float*)d_in[0]; p.c = (const float*)d_in[1]; p.w_ada = (const float*)d_in[2]; p.b_ada = (const float*)d_in[3];
  p.norm_gain = (const float*)d_in[4]; p.w_in = (const float*)d_in[5]; p.w_up = (const float*)d_in[6]; p.b_gate = (const float*)d_in[7];
  p.gla_gain = (const float*)d_in[8]; p.lq1 = (const float*)d_in[9]; p.lk1 = (const float*)d_in[10]; p.lq2 = (const float*)d_in[11];
  p.lk2 = (const float*)d_in[12]; p.diff_gain = (const float*)d_in[13]; p.w_out = (const float*)d_in[14]; p.final_gain = (const float*)d_in[15];
  p.out = (float*)d_out;
  unsigned char* w = (unsigned char*)d_ws; size_t off = 0;
  auto take = [&](size_t bytes) { void* r = w + off; off += (bytes + 255) & ~(size_t)255; return r; };
  p.modpart = (float*)take((size_t)8 * 16 * 3072 * 4);
  p.mod = (float*)take((size_t)16 * 3072 * 4);
  p.rowsq = (float*)take((size_t)NTOK * 4);
  p.la = (float*)take((size_t)NTOK * 256 * 4);
  p.winT = (bf16_t*)take((size_t)NP * 1024 * 2);
  p.woutT = (bf16_t*)take((size_t)1024 * 1024 * 2);
  p.h = (bf16_t*)take((size_t)NTOK * 1024 * 2);
  p.proj = (bf16_t*)take((size_t)NTOK * NP * 2);
  p.mix = (bf16_t*)take((size_t)NTOK * 1024 * 2);
  p.gvT = (bf16_t*)take((size_t)NTOK * 512 * 2);
  p.dvT = (bf16_t*)take((size_t)NTOK * 512 * 2);
  p.bar = (unsigned*)take((size_t)XCD_BAR_WORDS * 4 + 1024);
  p.ctr = p.bar + XCD_BAR_WORDS;
  p.pcnt = p.ctr + 64;
#if 0
  hipMemsetAsync(p.bar, 0, (size_t)XCD_BAR_WORDS * 4 + 1024, stream);
  for (int ph = 0; ph < 5; ++ph) {
    p.phase_lo = ph; p.phase_hi = ph;
    hipLaunchKernelGGL(fwd_kernel, dim3(grid_blocks), dim3(NTHREADS), LDS_BYTES, stream, p);
  }
#else
  p.phase_lo = 0; p.phase_hi = 4;
  hipMemsetAsync(p.bar, 0, (size_t)XCD_BAR_WORDS * 4 + 1024, stream);
  void* args[] = {&p};
  hipError_t e = hipLaunchCooperativeKernel((void*)fwd_kernel, dim3(grid_blocks), dim3(NTHREADS), args, LDS_BYTES, stream);
  if (e != hipSuccess) fprintf(stderr, "cooperative launch failed: %s (grid %d)\n", hipGetErrorString(e), grid_blocks);
#endif
}
```

```cpp
#include <hip/hip_runtime.h>
#include <hip/hip_cooperative_groups.h>
#include <cstdio>
#include <cstdint>
namespace cg = cooperative_groups;

typedef unsigned short bf16_t;
typedef short bf16x8 __attribute__((ext_vector_type(8)));
typedef float f32x4 __attribute__((ext_vector_type(4)));
typedef float f32x2 __attribute__((ext_vector_type(2)));
typedef __bf16 bf16v2 __attribute__((ext_vector_type(2)));
typedef unsigned u32x4 __attribute__((ext_vector_type(4)));
typedef unsigned u32x2 __attribute__((ext_vector_type(2)));

#define DI __device__ __forceinline__

constexpr int D_MODEL = 1024, BATCH = 16, SEQ = 2048, NTOK = BATCH * SEQ;
constexpr int D_IN = 3600, NP = 3584;
constexpr int C_GQ = 0, C_GK = 256, C_GV = 512, C_GZ = 1024, C_DQ = 1536, C_DK = 2048, C_DV = 2560, C_DZ = 3072;
constexpr int NTHREADS = 512;
constexpr int LDS_BYTES = 147456;
constexpr float EPS = 1e-6f;

struct Params {
  const float *x, *c, *w_ada, *b_ada, *norm_gain, *w_in, *w_up, *b_gate, *gla_gain, *lq1, *lk1, *lq2, *lk2, *diff_gain, *w_out, *final_gain;
  float* out;
  float* modpart;
  float* mod;
  float* rowsq;
  float* la;
  bf16_t* winT;
  bf16_t* woutT;
  bf16_t* h;
  bf16_t* proj;
  bf16_t* mix;
  bf16_t* gvT;
  bf16_t* dvT;
  unsigned* ctr;
  unsigned* bar;
  unsigned* pcnt;
  int phase_lo, phase_hi;
};

DI unsigned pk_bf16(float a, float b) { f32x2 v = {a, b}; bf16v2 r = __builtin_convertvector(v, bf16v2); return __builtin_bit_cast(unsigned, r); }
DI float bf_lo(unsigned u) { return __uint_as_float(u << 16); }
DI float bf_hi(unsigned u) { return __uint_as_float(u & 0xffff0000u); }
DI float bf2f(bf16_t u) { return __uint_as_float(((unsigned)u) << 16); }
DI float wave_sum(float v) {
#pragma unroll
  for (int o = 32; o >= 1; o >>= 1) v += __shfl_xor(v, o);
  return v;
}
DI float wave_max(float v) {
#pragma unroll
  for (int o = 32; o >= 1; o >>= 1) v = fmaxf(v, __shfl_xor(v, o));
  return v;
}
DI float silu_f(float v) { return v * __builtin_amdgcn_rcpf(1.f + __builtin_amdgcn_exp2f(-1.44269504f * v)); }

#define XB_TMO      128
#define XB_XCNT(j)  (256  + 64 * (j))
#define XB_XSUB(j)  (1280 + 64 * (j))
#define XB_XGEN(j)  (2304 + 64 * (j))
#define XB_TOP      3328
#define XB_TOPGEN   3392
#define XCD_BAR_WORDS 3456
#define XB_SPIN_CAP (1u << 20)
#define LAS __attribute__((address_space(3)))
DI unsigned xb_ld(unsigned* p)              { return __hip_atomic_load(p, __ATOMIC_RELAXED, __HIP_MEMORY_SCOPE_AGENT); }
DI unsigned xb_add(unsigned* p, unsigned v) { return __hip_atomic_fetch_add(p, v, __ATOMIC_RELAXED, __HIP_MEMORY_SCOPE_AGENT); }
DI unsigned xb_xcc_id() { return (unsigned)__builtin_amdgcn_s_getreg((3 << 11) | 20) & 0xFu; }
#define XB_SPIN(cond, bar) do { unsigned _sp = 0; while (cond) { __builtin_amdgcn_s_sleep(1); \
    if ((++_sp & 255u) == 0u) { if (xb_ld(&(bar)[XB_TMO])) break; if (_sp > XB_SPIN_CAP) { atomicAdd(&(bar)[XB_TMO], 1u); break; } } } } while (0)
DI void xcd_barrier_complete(unsigned* bar, unsigned x, unsigned& nloc, unsigned& nx) {
  const unsigned G = gridDim.x;
  unsigned sum, cnt, mine, sp = 0u;
  for (;;) {
    sum = 0u; cnt = 0u; mine = 0u;
#pragma unroll
    for (unsigned j = 0; j < 16; ++j) { const unsigned c = xb_ld(&bar[XB_XCNT(j)]); sum += c; cnt += (c > 0u) ? 1u : 0u; mine = (j == x) ? c : mine; }
    if (sum == G) break;
    __builtin_amdgcn_s_sleep(1);
    if ((++sp & 255u) == 0u) { if (xb_ld(&bar[XB_TMO])) break; if (sp > XB_SPIN_CAP) { atomicAdd(&bar[XB_TMO], 1u); break; } }
  }
  nloc = mine > 0u ? mine : 1u; nx = cnt > 0u ? cnt : 1u;
}
DI void xcd_barrier(unsigned* bar, volatile LAS unsigned* st) {
  asm volatile("s_waitcnt vmcnt(0)" ::: "memory");
  __syncthreads();
  if (threadIdx.x == 0) {
    const unsigned x = xb_xcc_id();
    __builtin_amdgcn_s_waitcnt(0);
    unsigned nloc = st[0], nx = st[1];
    if (nloc == 0u) { xcd_barrier_complete(bar, x, nloc, nx); st[0] = nloc; st[1] = nx; }
    const unsigned old = xb_add(&bar[XB_XSUB(x)], 1u);
    const unsigned gen = old / nloc;
    if (old + 1u == (gen + 1u) * nloc) {
      __builtin_amdgcn_fence(__ATOMIC_RELEASE, "agent");
      asm volatile("s_waitcnt vmcnt(0)" ::: "memory");
      const unsigned og = xb_add(&bar[XB_TOP], 1u);
      const unsigned tg = og / nx;
      if (og + 1u == (tg + 1u) * nx) xb_add(&bar[XB_TOPGEN], 1u);
      else XB_SPIN(xb_ld(&bar[XB_TOPGEN]) == tg, bar);
      __builtin_amdgcn_fence(__ATOMIC_ACQUIRE, "agent");
      xb_add(&bar[XB_XGEN(x)], 1u);
      asm volatile("s_waitcnt vmcnt(0)" ::: "memory");
    } else {
      XB_SPIN(xb_ld(&bar[XB_XGEN(x)]) == gen, bar);
      __builtin_amdgcn_fence(__ATOMIC_ACQUIRE, "agent");
      asm volatile("s_waitcnt vmcnt(0)" ::: "memory");
    }
  }
  __syncthreads();
}

DI int fresh_tid() { int t = threadIdx.x; asm volatile("" : "+v"(t)); return t; }

DI int perm32(int r) { return 8 * ((r & 15) >> 2) + 4 * (r >> 4) + (r & 3); }
DI int inv32(int a) { return ((a >> 2) & 1) * 16 + (a >> 3) * 4 + (a & 3); }

DI void phase0a(const Params& p, unsigned char* smem, const int t) {
  for (int i = blockIdx.x * NTHREADS + t; i < NTOK; i += gridDim.x * NTHREADS) p.rowsq[i] = 0.f;
  constexpr int N_MOD = 192, N_WIN = 16 * 56, N_WOUT = 16 * 16;
  for (int item = blockIdx.x; item < N_MOD + N_WIN + N_WOUT; item += gridDim.x) {
    __syncthreads();
    if (item < N_MOD) {
      const int nc = item % 24, ks = item / 24, n0 = nc * 128, k0 = ks * 128;
      float* sc = (float*)smem;
      float* red = sc + 16 * 128;
      for (int e = t; e < 2048; e += NTHREADS) { const int b = e >> 7, kk = e & 127; sc[e] = silu_f(p.c[b * 1024 + k0 + kk]); }
      __syncthreads();
      const int nl = t & 127, sub = t >> 7;
      float acc[16];
#pragma unroll
      for (int b = 0; b < 16; ++b) acc[b] = 0.f;
      for (int kk = sub * 32; kk < sub * 32 + 32; ++kk) {
        const float w = __builtin_nontemporal_load(p.w_ada + (size_t)(k0 + kk) * 3072 + n0 + nl);
#pragma unroll
        for (int b = 0; b < 16; ++b) acc[b] += sc[b * 128 + kk] * w;
      }
#pragma unroll
      for (int b = 0; b < 16; ++b) red[(sub * 16 + b) * 128 + nl] = acc[b];
      __syncthreads();
      for (int e = t; e < 2048; e += NTHREADS) {
        const int b = e >> 7, n = e & 127;
        p.modpart[((size_t)ks * 16 + b) * 3072 + n0 + n] = red[(0 * 16 + b) * 128 + n] + red[(1 * 16 + b) * 128 + n] + red[(2 * 16 + b) * 128 + n] + red[(3 * 16 + b) * 128 + n];
      }
    } else {
      const float* src; bf16_t* dst; int ld, k0, n0, ncol;
      if (item < N_MOD + N_WIN) { const int it = item - N_MOD; k0 = (it % 16) * 64; n0 = (it / 16) * 64; src = p.w_in; ld = D_IN; dst = p.winT; ncol = n0 < C_DQ ? n0 : n0 + 16; }
      else { const int it = item - N_MOD - N_WIN; k0 = (it % 16) * 64; n0 = (it / 16) * 64; src = p.w_out; ld = 1024; dst = p.woutT; ncol = n0; }
      float* tile = (float*)smem;
#pragma unroll
      for (int e = 0; e < 8; ++e) { const int idx = e * NTHREADS + t, r = idx >> 6, cc = idx & 63; tile[r * 65 + cc] = __builtin_nontemporal_load(src + (size_t)(k0 + r) * ld + ncol + cc); }
      __syncthreads();
      const int n = t >> 3, ksg = (t & 7) * 8;
      const int ns = (src == p.w_in) ? ((n & ~31) | perm32(n & 31)) : n;
      u32x4 w;
      w.x = pk_bf16(tile[(ksg + 0) * 65 + ns], tile[(ksg + 1) * 65 + ns]);
      w.y = pk_bf16(tile[(ksg + 2) * 65 + ns], tile[(ksg + 3) * 65 + ns]);
      w.z = pk_bf16(tile[(ksg + 4) * 65 + ns], tile[(ksg + 5) * 65 + ns]);
      w.w = pk_bf16(tile[(ksg + 6) * 65 + ns], tile[(ksg + 7) * 65 + ns]);
      *(u32x4*)(dst + (size_t)(n0 + n) * 1024 + k0 + ksg) = w;
    }
  }
}

DI void phase0b(const Params& p, unsigned char* smem, const int t) {
  const int lane = t & 63, wid = t >> 6;
  for (int i = blockIdx.x * NTHREADS + t; i < 16 * 3072; i += gridDim.x * NTHREADS) {
    float s = p.b_ada[i % 3072];
#pragma unroll
    for (int ks = 0; ks < 8; ++ks) s += p.modpart[(size_t)ks * 16 * 3072 + i];
    p.mod[i] = s;
  }
  float* g = (float*)smem;
  float* sh = g + 1024;
  float* wg = sh + 1024;
  f32x4 wup[16];
#pragma unroll
  for (int r = 0; r < 16; ++r) wup[r] = *(const f32x4*)(p.w_up + r * 256 + lane * 4);
  const f32x4 bgv = *(const f32x4*)(p.b_gate + lane * 4);
  for (int item = blockIdx.x; item < NTOK / 128; item += gridDim.x) {
    const int b = item / 16, row0 = item * 128;
    __syncthreads();
    for (int k = t; k < 1024; k += NTHREADS) {
      float s_sh = p.b_ada[k], s_sc = p.b_ada[1024 + k];
#pragma unroll
      for (int ks = 0; ks < 8; ++ks) { s_sh += p.modpart[((size_t)ks * 16 + b) * 3072 + k]; s_sc += p.modpart[((size_t)ks * 16 + b) * 3072 + 1024 + k]; }
      g[k] = p.norm_gain[k] * (1.f + s_sc); sh[k] = s_sh;
    }
    for (int e = t; e < 4096; e += NTHREADS) {
      const int r = e & 15, L = (e >> 4) & 63, i = e >> 10, k = i * 256 + 4 * L;
      const float* wp = p.w_in + (size_t)k * D_IN + 1536 + r;
      u32x2 w; w.x = pk_bf16(wp[0], wp[D_IN]); w.y = pk_bf16(wp[2 * D_IN], wp[3 * D_IN]);
      *(u32x2*)((unsigned char*)wg + (i * 64 + L) * 128 + (((r >> 1) ^ ((L >> 1) & 7)) << 4) + (r & 1) * 8) = w;
    }
    __syncthreads();
    f32x4 xn[4];
#pragma unroll
    for (int i = 0; i < 4; ++i) xn[i] = __builtin_nontemporal_load((const f32x4*)(p.x + (size_t)(row0 + wid) * 1024 + i * 256 + lane * 4));
    for (int rr = wid; rr < 128; rr += 8) {
      const size_t row = row0 + rr;
      const size_t hrow = (row & ~(size_t)31) | (size_t)inv32((int)(row & 31));
      f32x4 xv[4];
#pragma unroll
      for (int i = 0; i < 4; ++i) xv[i] = xn[i];
      if (rr + 8 < 128) {
#pragma unroll
        for (int i = 0; i < 4; ++i) xn[i] = __builtin_nontemporal_load((const f32x4*)(p.x + (row + 8) * 1024 + i * 256 + lane * 4));
      }
      float ss = 0.f;
#pragma unroll
      for (int i = 0; i < 4; ++i) ss += xv[i][0] * xv[i][0] + xv[i][1] * xv[i][1] + xv[i][2] * xv[i][2] + xv[i][3] * xv[i][3];
      ss = wave_sum(ss);
      const float rstd = rsqrtf(ss * (1.f / 1024.f) + EPS);
      float pr[16];
#pragma unroll
      for (int r = 0; r < 16; ++r) pr[r] = 0.f;
#pragma unroll
      for (int i = 0; i < 4; ++i) {
        const int k = i * 256 + lane * 4;
        const f32x4 gv = *(const f32x4*)(g + k), sv = *(const f32x4*)(sh + k);
        const f32x4 hv = xv[i] * rstd * gv + sv;
        u32x2 w; w.x = pk_bf16(hv[0], hv[1]); w.y = pk_bf16(hv[2], hv[3]);
        *(u32x2*)(p.h + hrow * 1024 + k) = w;
        const unsigned char* wrow = (const unsigned char*)wg + (i * 64 + lane) * 128;
#pragma unroll
        for (int c = 0; c < 8; ++c) {
          const u32x4 wv = *(const u32x4*)(wrow + ((c ^ ((lane >> 1) & 7)) << 4));
          asm volatile("v_dot2c_f32_bf16 %0, %1, %2" : "+v"(pr[2 * c]) : "v"(w.x), "v"(wv.x));
          asm volatile("v_dot2c_f32_bf16 %0, %1, %2" : "+v"(pr[2 * c]) : "v"(w.y), "v"(wv.y));
          asm volatile("v_dot2c_f32_bf16 %0, %1, %2" : "+v"(pr[2 * c + 1]) : "v"(w.x), "v"(wv.z));
          asm volatile("v_dot2c_f32_bf16 %0, %1, %2" : "+v"(pr[2 * c + 1]) : "v"(w.y), "v"(wv.w));
        }
        __builtin_amdgcn_sched_barrier(0);
      }
      float a8[8], a4[4], a2[2], a1;
      { const bool hi = lane & 1;
#pragma unroll
        for (int i = 0; i < 8; ++i) { const float keep = hi ? pr[i + 8] : pr[i], send = hi ? pr[i] : pr[i + 8]; a8[i] = keep + __shfl_xor(send, 1); } }
      { const bool hi = lane & 2;
#pragma unroll
        for (int i = 0; i < 4; ++i) { const float keep = hi ? a8[i + 4] : a8[i], send = hi ? a8[i] : a8[i + 4]; a4[i] = keep + __shfl_xor(send, 2); } }
      { const bool hi = lane & 4;
#pragma unroll
        for (int i = 0; i < 2; ++i) { const float keep = hi ? a4[i + 2] : a4[i], send = hi ? a4[i] : a4[i + 2]; a2[i] = keep + __shfl_xor(send, 4); } }
      { const bool hi = lane & 8; const float keep = hi ? a2[1] : a2[0], send = hi ? a2[0] : a2[1]; a1 = keep + __shfl_xor(send, 8); }
      a1 += __shfl_xor(a1, 16); a1 += __shfl_xor(a1, 32);
      float* grs = (float*)(smem + 73728) + wid * 16;
      if (lane < 16) grs[8 * (lane & 1) + 4 * ((lane >> 1) & 1) + 2 * ((lane >> 2) & 1) + ((lane >> 3) & 1)] = a1;
      const f32x4 g0 = *(const f32x4*)(grs), g1 = *(const f32x4*)(grs + 4), g2 = *(const f32x4*)(grs + 8), g3 = *(const f32x4*)(grs + 12);
      f32x4 lg = bgv;
#pragma unroll
      for (int j = 0; j < 4; ++j) {
        lg += g0[j] * wup[j] + g1[j] * wup[4 + j] + g2[j] * wup[8 + j] + g3[j] * wup[12 + j];
      }
      f32x4 lav;
#pragma unroll
      for (int j = 0; j < 4; ++j) lav[j] = (fminf(lg[j], 0.f) - __logf(1.f + __expf(-fabsf(lg[j])))) * (1.f / 16.f);
      __builtin_nontemporal_store(lav, (f32x4*)(p.la + row * 256 + lane * 4));
    }
  }
}

constexpr int BM = 256, BK = 64, HALF = 128, NXCD = 8, WGM = 8, HT = HALF * BK;
DI int lds_byte(int r, int c) { int st = (r >> 4) * 2 + (c >> 5), rr = r & 15, cc = c & 31, ob = rr * 64 + cc * 2; return st * 1024 + (ob ^ (((ob >> 9) & 1) << 5)); }
DI void stage_rc(int b, int& R, int& C) { int st = b / 1024, sb = b % 1024, swz = sb ^ (((sb >> 9) & 1) << 5); R = (st >> 1) * 16 + swz / 64; C = (st & 1) * 32 + (swz % 64) / 2; }

template <class Epi>
DI void gemm_tile(const bf16_t* __restrict__ A, const bf16_t* __restrict__ Bt, const int K, const int brow, const int bcol, const Epi& epi) {
  extern __shared__ __attribute__((aligned(16))) unsigned char smem[];
  bf16_t* shm = (bf16_t*)smem;
#define SA(b, h) (shm + ((b) * 2 + (h)) * HT)
#define SB(b, h) (shm + (4 + (b) * 2 + (h)) * HT)
#define STAGE(P, BASE, br, kt) do { const bf16_t* _gb = (BASE) + ((long)(br) * K + (long)(kt) * BK); \
    __builtin_amdgcn_global_load_lds((const unsigned*)(_gb + toff0), (unsigned*)((char*)(P) + tb16), 16, 0, 0); \
    __builtin_amdgcn_global_load_lds((const unsigned*)(_gb + toff1), (unsigned*)((char*)(P) + tb16 + 8192), 16, 0, 0); } while (0)
#define LDA(dst, b, h) for (int m = 0; m < 4; ++m) for (int k = 0; k < 2; ++k) \
    dst[m][k] = *reinterpret_cast<const bf16x8*>(smem + a_base_ + (((b) * 2 + (h)) * 16384 + m * 2048 + k * 1024))
#define LDB(dst, b, h) for (int n = 0; n < 2; ++n) for (int k = 0; k < 2; ++k) \
    dst[n][k] = *reinterpret_cast<const bf16x8*>(smem + b_base_ + (((b) * 2 + (h)) * 16384 + n * 2048 + k * 1024))
#define MMA(ai, bj, At, Bt_) do { __builtin_amdgcn_s_setprio(1); \
    for (int m = 0; m < 4; ++m) for (int n = 0; n < 2; ++n) for (int k = 0; k < 2; ++k) \
      acc[ai][bj][m][n] = __builtin_amdgcn_mfma_f32_16x16x32_bf16(Bt_[n][k], At[m][k], acc[ai][bj][m][n], 0, 0, 0); \
    __builtin_amdgcn_s_setprio(0); } while (0)
#define WAIT_V(n) asm volatile("s_waitcnt vmcnt(" #n ")" ::: "memory")
#define WAIT_L(n) asm volatile("s_waitcnt lgkmcnt(" #n ")" ::: "memory")
#define BAR __builtin_amdgcn_s_barrier()
#define SCHED __builtin_amdgcn_sched_barrier(0)
  const int tid = fresh_tid();
  const int wid = tid >> 6, lane = tid & 63, wr = wid >> 2, wc = wid & 3, fr = lane & 15, fq = lane >> 4;
  const int tb16 = tid * 16;
  const unsigned a_base = (unsigned)lds_byte(wr * 64 + fr, fq * 8), b_base = 65536u + (unsigned)lds_byte(wc * 32 + fr, fq * 8);
  unsigned a_base_ = a_base, b_base_ = b_base; asm volatile("" : "+v"(a_base_), "+v"(b_base_));
  unsigned toff0, toff1;
  { int r0, c0, r1, c1; stage_rc(tb16, r0, c0); stage_rc(tb16 + 8192, r1, c1); toff0 = (unsigned)(r0 * K + c0); toff1 = (unsigned)(r1 * K + c1); }
  f32x4 acc[2][2][4][2] = {};
  bf16x8 At[4][2], B0[2][2], B1[2][2];
  const int nt = K / BK;
  STAGE(SB(0, 0), Bt, bcol, 0); STAGE(SA(0, 0), A, brow, 0);
  STAGE(SB(0, 1), Bt, bcol + HALF, 0); STAGE(SA(0, 1), A, brow + HALF, 0);
  if (wr == 1) BAR;
  WAIT_V(4); BAR;
  STAGE(SB(1, 0), Bt, bcol, 1); STAGE(SA(1, 0), A, brow, 1); STAGE(SB(1, 1), Bt, bcol + HALF, 1);
  WAIT_V(6); BAR;
  for (int t = 0; t < nt - 2; t += 2) {
    LDB(B0, 0, 0); SCHED; LDA(At, 0, 0); STAGE(SA(1, 1), A, brow + HALF, t + 1);
    WAIT_L(8); BAR; WAIT_L(0); MMA(0, 0, At, B0); BAR; SCHED;
    LDB(B1, 0, 1); STAGE(SB(0, 0), Bt, bcol, t + 2);
    BAR; WAIT_L(0); MMA(0, 1, At, B1); BAR;
    LDA(At, 0, 1); STAGE(SA(0, 0), A, brow, t + 2);
    BAR; WAIT_L(0); MMA(1, 0, At, B0); BAR; SCHED;
    STAGE(SB(0, 1), Bt, bcol + HALF, t + 2);
    WAIT_V(6); BAR; MMA(1, 1, At, B1); BAR;
    LDB(B0, 1, 0); SCHED; LDA(At, 1, 0); STAGE(SA(0, 1), A, brow + HALF, t + 2);
    WAIT_L(8); BAR; WAIT_L(0); MMA(0, 0, At, B0); BAR; SCHED;
    LDB(B1, 1, 1); STAGE(SB(1, 0), Bt, bcol, t + 3);
    BAR; WAIT_L(0); MMA(0, 1, At, B1); BAR;
    LDA(At, 1, 1); STAGE(SA(1, 0), A, brow, t + 3);
    BAR; WAIT_L(0); MMA(1, 0, At, B0); BAR; SCHED;
    STAGE(SB(1, 1), Bt, bcol + HALF, t + 3);
    WAIT_V(6); BAR; MMA(1, 1, At, B1); BAR;
  }
  { LDB(B0, 0, 0); LDA(At, 0, 0); STAGE(SA(1, 1), A, brow + HALF, nt - 1);
    BAR; WAIT_L(0); MMA(0, 0, At, B0); BAR;
    LDB(B1, 0, 1); BAR; WAIT_L(0); MMA(0, 1, At, B1); BAR;
    LDA(At, 0, 1); WAIT_V(4); BAR; WAIT_L(0); MMA(1, 0, At, B0); MMA(1, 1, At, B1); BAR; }
  { LDB(B0, 1, 0); LDA(At, 1, 0); WAIT_V(2); BAR; WAIT_L(0); MMA(0, 0, At, B0); BAR;
    LDB(B1, 1, 1); WAIT_V(0); BAR; WAIT_L(0); MMA(0, 1, At, B1); BAR;
    LDA(At, 1, 1); BAR; WAIT_L(0); MMA(1, 0, At, B0); MMA(1, 1, At, B1); BAR; }
  if (wr == 0) BAR;
  { int tid2 = threadIdx.x; asm volatile("" : "+v"(tid2));
    const int wid2 = tid2 >> 6, lane2 = tid2 & 63;
    epi(acc, brow, bcol, (wid2 >> 2) * 64, lane2 & 15, (wid2 & 3) * 32 + (lane2 >> 4) * 8, lane2); }
#undef SA
#undef SB
#undef STAGE
#undef LDA
#undef LDB
#undef MMA
}

DI bool tile_order(int i, int G, int c, int nM, int nN, int& pm, int& pn) {
  const int nwg = nM * nN; const long L = (long)i * G + c; if (L >= nwg) return false;
  int wgid = (int)L; { const int q = nwg / NXCD, r = nwg % NXCD, xcd = wgid % NXCD, off = wgid / NXCD; wgid = (xcd < r ? xcd * (q + 1) : r * (q + 1) + (xcd - r) * q) + off; }
  const int nig = WGM * nN, gid = wgid / nig, fm = gid * WGM, gsz = (nM - fm) < WGM ? (nM - fm) : WGM;
  pm = fm + ((wgid % nig) % gsz); pn = (wgid % nig) / gsz; return true;
}

struct EpiProj {
  bf16_t* O; bf16_t* gvT; bf16_t* dvT; int vmode;
  DI void operator()(f32x4 (&acc)[2][2][4][2], int brow, int bcol, int rw, int fr, int cw, int lane) const {
    const int rperm = 8 * (fr >> 2) + (fr & 3);
    if (vmode == 0) {
      const bool sil = (bcol >= C_GZ && bcol < C_DQ) || (bcol >= C_DZ);
#pragma unroll
      for (int ai = 0; ai < 2; ++ai)
#pragma unroll
        for (int m = 0; m < 4; ++m) {
          const int row = brow + ai * HALF + rw + (m >> 1) * 32 + 4 * (m & 1) + rperm;
          bf16_t* rp = O + (size_t)row * NP + bcol + cw;
#pragma unroll
          for (int bj = 0; bj < 2; ++bj) {
            f32x4 v0 = acc[ai][bj][m][0], v1 = acc[ai][bj][m][1];
            if (sil) {
#pragma unroll
              for (int j = 0; j < 4; ++j) { v0[j] = silu_f(v0[j]); v1[j] = silu_f(v1[j]); }
            }
            u32x4 w; w.x = pk_bf16(v0[0], v0[1]); w.y = pk_bf16(v0[2], v0[3]); w.z = pk_bf16(v1[0], v1[1]); w.w = pk_bf16(v1[2], v1[3]);
            *(u32x4*)(rp + bj * HALF) = w;
          }
        }
    } else {
      bf16_t* T = (vmode == 1) ? gvT : dvT;
      const int vbase = brow - ((vmode == 1) ? C_GV : C_DV);
      const int b = bcol / SEQ, s0 = bcol % SEQ + cw;
#pragma unroll
      for (int ai = 0; ai < 2; ++ai)
#pragma unroll
        for (int m = 0; m < 4; ++m) {
          const int v = vbase + ai * HALF + rw + (m >> 1) * 32 + 4 * (m & 1) + rperm;
          bf16_t* rp = T + ((size_t)b * 512 + v) * SEQ + s0;
#pragma unroll
          for (int bj = 0; bj < 2; ++bj) {
            const f32x4 v0 = acc[ai][bj][m][0], v1 = acc[ai][bj][m][1];
            u32x4 w; w.x = pk_bf16(v0[0], v0[1]); w.y = pk_bf16(v0[2], v0[3]); w.z = pk_bf16(v1[0], v1[1]); w.w = pk_bf16(v1[2], v1[3]);
            *(u32x4*)(rp + bj * HALF) = w;
          }
        }
    }
  }
};
struct EpiOut {
  const float* x; const float* mod; const float* fgain; float* out; float* rowsq; unsigned* pcnt;
  DI void operator()(f32x4 (&acc)[2][2][4][2], int brow, int bcol, int rw, int fr, int cwp, int lane) const {
    extern __shared__ __attribute__((aligned(16))) unsigned char smem[];
    constexpr int TS = 1040;
    const int b = brow / SEQ, wid = threadIdx.x >> 6;
    const int cw = (cwp & ~31) + ((cwp & 31) >> 1);
    f32x4 gt[2][2];
#pragma unroll
    for (int bj = 0; bj < 2; ++bj)
#pragma unroll
      for (int n = 0; n < 2; ++n) gt[bj][n] = *(const f32x4*)(mod + (size_t)b * 3072 + 2048 + bcol + cw + bj * HALF + n * 16);
    f32x4 Y[2][16];
    float myss[2] = {0.f, 0.f};
    __syncthreads();
#pragma unroll
    for (int ai = 0; ai < 2; ++ai) {
      const float* xb = x + (size_t)(brow + ai * HALF + wid * 16) * 1024 + bcol + lane * 4;
#pragma unroll
      for (int i = 0; i < 16; ++i) Y[ai][i] = __builtin_nontemporal_load((const f32x4*)(xb + (size_t)i * 1024));
#pragma unroll
      for (int m = 0; m < 4; ++m)
#pragma unroll
        for (int bj = 0; bj < 2; ++bj)
#pragma unroll
          for (int n = 0; n < 2; ++n)
            *(f32x4*)(smem + (rw + m * 16 + fr) * TS + (bj * HALF + cw + n * 16) * 4) = gt[bj][n] * acc[ai][bj][m][n];
      __syncthreads();
#pragma unroll
      for (int i = 0; i < 16; ++i) {
        const f32x4 v = *(const f32x4*)(smem + (wid * 16 + i) * TS + lane * 16);
        const f32x4 y = Y[ai][i] + v; Y[ai][i] = y;
        const float ss = wave_sum(y[0] * y[0] + y[1] * y[1] + y[2] * y[2] + y[3] * y[3]);
        if (lane == i) myss[ai] = ss;
      }
      __syncthreads();
    }
    if (lane < 16) {
      (void)__hip_atomic_fetch_add(rowsq + (size_t)(brow + wid * 16 + lane), myss[0], __ATOMIC_RELAXED, __HIP_MEMORY_SCOPE_AGENT);
      (void)__hip_atomic_fetch_add(rowsq + (size_t)(brow + HALF + wid * 16 + lane), myss[1], __ATOMIC_RELAXED, __HIP_MEMORY_SCOPE_AGENT);
    }
    asm volatile("s_waitcnt vmcnt(0)" ::: "memory");
    __syncthreads();
    if (threadIdx.x == 0) {
      unsigned* c = pcnt + (brow >> 8);
      (void)__hip_atomic_fetch_add(c, 1u, __ATOMIC_RELAXED, __HIP_MEMORY_SCOPE_AGENT);
      unsigned sp = 0;
      while (__hip_atomic_load(c, __ATOMIC_RELAXED, __HIP_MEMORY_SCOPE_AGENT) < 4u) { __builtin_amdgcn_s_sleep(1); if (++sp > (1u << 22)) break; }
    }
    __syncthreads();
    float rn[2] = {0.f, 0.f};
    if (lane < 16) {
      rn[0] = rsqrtf(__hip_atomic_load(rowsq + (size_t)(brow + wid * 16 + lane), __ATOMIC_RELAXED, __HIP_MEMORY_SCOPE_AGENT) * (1.f / 1024.f) + EPS);
      rn[1] = rsqrtf(__hip_atomic_load(rowsq + (size_t)(brow + HALF + wid * 16 + lane), __ATOMIC_RELAXED, __HIP_MEMORY_SCOPE_AGENT) * (1.f / 1024.f) + EPS);
    }
    const f32x4 fg = *(const f32x4*)(fgain + bcol + lane * 4);
#pragma unroll
    for (int ai = 0; ai < 2; ++ai) {
      float* ob = out + (size_t)(brow + ai * HALF + wid * 16) * 1024 + bcol + lane * 4;
#pragma unroll
      for (int i = 0; i < 16; ++i) __builtin_nontemporal_store(Y[ai][i] * __shfl(rn[ai], i) * fg, (f32x4*)(ob + (size_t)i * 1024));
    }
  }
};

DI void gemm1_phase(const Params& p) {
  for (int i = 0;; ++i) {
    int pm, pn; if (!tile_order(i, gridDim.x, blockIdx.x, NTOK / BM, NP / BM, pm, pn)) break;
    const int vmode = (pn == 2 || pn == 3) ? 1 : ((pn == 10 || pn == 11) ? 2 : 0);
    const bf16_t* A = vmode ? p.winT : p.h; const bf16_t* Bt = vmode ? p.h : p.winT;
    const int brow = vmode ? pn * BM : pm * BM, bcol = vmode ? pm * BM : pn * BM;
    gemm_tile(A, Bt, 1024, brow, bcol, EpiProj{p.proj, p.gvT, p.dvT, vmode});
  }
}
DI void gemm2_phase(const Params& p) {
  for (int i = 0;; ++i) {
    int pm, pn; if (!tile_order(i, gridDim.x, blockIdx.x, NTOK / BM, 1024 / BM, pm, pn)) break;
    gemm_tile(p.mix, p.woutT, 1024, pm * BM, pn * BM, EpiOut{p.x, p.mod, p.final_gain, p.out, p.rowsq, p.pcnt});
  }
}

DI float lam_value(const Params& p, const int t) {
  const int i = t & 63;
  const float s1 = wave_sum(p.lq1[i] * p.lk1[i]), s2 = wave_sum(p.lq2[i] * p.lk2[i]);
  return __expf(s1) - __expf(s2) + 0.2f;
}

#define LBAR() do { asm volatile("s_waitcnt lgkmcnt(0)" ::: "memory"); __builtin_amdgcn_s_barrier(); asm volatile("" ::: "memory"); } while (0)

typedef float f32x16 __attribute__((ext_vector_type(16)));
#define MFMA32(a, b, c) __builtin_amdgcn_mfma_f32_32x32x16_bf16((a), (b), (c), 0, 0, 0)
constexpr int AT_KB = 16384, AT_VB = 16384, AT_BUF = AT_KB + AT_VB;

DI bf16x8 pack8(const f32x16& x, int s) {
  u32x4 p; p.x = pk_bf16(x[8 * s], x[8 * s + 1]); p.y = pk_bf16(x[8 * s + 2], x[8 * s + 3]); p.z = pk_bf16(x[8 * s + 4], x[8 * s + 5]); p.w = pk_bf16(x[8 * s + 6], x[8 * s + 7]);
  return __builtin_bit_cast(bf16x8, p);
}
DI int swap23(int x) { return (x & ~12) | ((x & 4) << 1) | ((x & 8) >> 1); }

constexpr int AT_K0 = 0, AT_V0 = 49152;
DI void attn_item(const Params& p, const int bh, const int qb, const float lam, unsigned char* smem, const int t) {
  const int lane = t & 63, wid = t >> 6, r32 = lane & 31, hl = lane >> 5;
  const int qg = wid & 3, mp = wid >> 2;
  const int b = bh >> 2, hd = bh & 3;
  const size_t tokb = (size_t)b * SEQ;
  const int q0 = qb * 128 + qg * 32, iq = q0 + r32;
  const float slope2 = exp2f(-2.f * (hd + 1)) * 1.44269504f;
  const f32x2 c1v = {0.125f * 1.44269504f, 0.125f * 1.44269504f};
  bf16x8 qf[4];
  {
    const bf16_t* qp = p.proj + (tokb + iq) * NP + C_DQ + hd * 128 + mp * 64 + hl * 8;
#pragma unroll
    for (int sl = 0; sl < 4; ++sl) qf[sl] = *(const bf16x8*)(qp + sl * 16);
  }
  f32x2 kb[8];
#pragma unroll
  for (int i = 0; i < 8; ++i) { const int kof = 16 * ((2 * i) >> 3) + ((2 * i) & 7) + 8 * hl; kb[i] = (f32x2){slope2 * (float)kof, slope2 * (float)(kof + 1)}; }
  f32x16 O[4];
#pragma unroll
  for (int dt = 0; dt < 4; ++dt)
#pragma unroll
    for (int r = 0; r < 16; ++r) O[dt][r] = 0.f;
  float mrun = 0.f, lrun = 0.f;
  const int L0 = wid * 128 + lane, L1 = L0 + 64;
  const int kr0 = L0 >> 4, kr1 = L1 >> 4;
  const bf16_t* kg0 = p.proj + (tokb + kr0) * NP + C_DK + hd * 128 + (((L0 & 15) ^ (kr0 & 15)) << 3);
  const bf16_t* kg1 = p.proj + (tokb + kr1) * NP + C_DK + hd * 128 + (((L1 & 15) ^ (kr1 & 15)) << 3);
  const int vr0 = L0 >> 3, vr1 = L1 >> 3;
  const bf16_t* vg0 = p.dvT + ((size_t)bh * 128 + vr0) * SEQ + (((L0 & 7) ^ ((vr0 >> 1) & 7)) << 3);
  const bf16_t* vg1 = p.dvT + ((size_t)bh * 128 + vr1) * SEQ + (((L1 & 7) ^ ((vr1 >> 1) & 7)) << 3);
  const unsigned wslot = wid * 2048;
#define AT_STAGE(kbo, vbo, jt_) do { \
    __builtin_amdgcn_global_load_lds((const unsigned*)(kg0 + (size_t)(jt_) * 64 * NP), (unsigned*)(smem + (kbo) + wslot), 16, 0, 0); \
    __builtin_amdgcn_global_load_lds((const unsigned*)(kg1 + (size_t)(jt_) * 64 * NP), (unsigned*)(smem + (kbo) + wslot + 1024), 16, 0, 0); \
    __builtin_amdgcn_global_load_lds((const unsigned*)(vg0 + (jt_) * 64), (unsigned*)(smem + (vbo) + wslot), 16, 0, 0); \
    __builtin_amdgcn_global_load_lds((const unsigned*)(vg1 + (jt_) * 64), (unsigned*)(smem + (vbo) + wslot + 1024), 16, 0, 0); } while (0)
  const int krow = swap23(r32);
  const unsigned kread = (krow * 256) | ((((krow & 15) ^ hl) << 4) ^ (mp << 7));
  const unsigned vread = r32 * 128 + ((hl ^ ((r32 >> 1) & 7)) << 4);
  const int nt = 2 * qb + 2, wnt = 2 * qb + (qg >> 1) + 1;
#define AT_QK(kbuf_) do { \
    bf16x8 kq0[4], kq1[4]; \
    _Pragma("unroll") for (int sl = 0; sl < 4; ++sl) { \
      kq0[sl] = *(const bf16x8*)((kbuf_) + (kread ^ (unsigned)((sl * 2) << 4))); \
      kq1[sl] = *(const bf16x8*)((kbuf_) + 8192 + (kread ^ (unsigned)((sl * 2) << 4))); } \
    _Pragma("unroll") for (int r = 0; r < 16; ++r) { S0[r] = 0.f; S1[r] = 0.f; } \
    __builtin_amdgcn_sched_barrier(0); \
    _Pragma("unroll") for (int sl = 0; sl < 4; ++sl) { S0 = MFMA32(kq0[sl], qf[sl], S0); S1 = MFMA32(kq1[sl], qf[sl], S1); } } while (0)
#define AT_SOFTMAX(DIAG) do { \
    const int dj = jt * 64 + 8 * hl - iq; \
    const float dls = slope2 * (float)(jt * 64 - iq) - mrun; \
    const f32x2 dl0 = {dls, dls}, dl1 = {dls + slope2 * 32.f, dls + slope2 * 32.f}; \
    float mx = -1e30f; \
    _Pragma("unroll") for (int i = 0; i < 8; ++i) { \
      const int kof = 16 * ((2 * i) >> 3) + ((2 * i) & 7); \
      f32x2 u0 = (f32x2){S0[2 * i], S0[2 * i + 1]} * c1v + (kb[i] + dl0), u1 = (f32x2){S1[2 * i], S1[2 * i + 1]} * c1v + (kb[i] + dl1); \
      if (DIAG) { if (dj + kof > 0) u0.x = -1e30f; if (dj + kof + 1 > 0) u0.y = -1e30f; if (dj + 32 + kof > 0) u1.x = -1e30f; if (dj + 33 + kof > 0) u1.y = -1e30f; } \
      S0[2 * i] = u0.x; S0[2 * i + 1] = u0.y; S1[2 * i] = u1.x; S1[2 * i + 1] = u1.y; \
      mx = fmaxf(fmaxf(mx, u0.x), fmaxf(u0.y, fmaxf(u1.x, u1.y))); } \
    mx = fmaxf(mx, __shfl_xor(mx, 32)); \
    live = first || !__all(mx < -60.f);     \
    if (!live) break; \
    if (__any(mx > 8.f) || first) { \
      const float inc = first ? mx : fmaxf(mx, 0.f), al = first ? 0.f : __builtin_amdgcn_exp2f(-inc);     \
      mrun += inc; lrun *= al; \
      _Pragma("unroll") for (int dt = 0; dt < 4; ++dt) _Pragma("unroll") for (int r = 0; r < 16; ++r) O[dt][r] *= al; \
      _Pragma("unroll") for (int r = 0; r < 16; ++r) { S0[r] -= inc; S1[r] -= inc; } } \
    f32x2 ls2 = {0.f, 0.f}; \
    _Pragma("unroll") for (int i = 0; i < 8; ++i) { \
      const f32x2 p0 = {__builtin_amdgcn_exp2f(S0[2 * i]), __builtin_amdgcn_exp2f(S0[2 * i + 1])}, p1 = {__builtin_amdgcn_exp2f(S1[2 * i]), __builtin_amdgcn_exp2f(S1[2 * i + 1])}; \
      S0[2 * i] = p0.x; S0[2 * i + 1] = p0.y; S1[2 * i] = p1.x; S1[2 * i + 1] = p1.y; ls2 += p0 + p1; } \
    lrun += ls2.x + ls2.y; \
    pf[0] = pack8(S0, 0); pf[1] = pack8(S0, 1); pf[2] = pack8(S1, 0); pf[3] = pack8(S1, 1); } while (0)
#define AT_VLD(dst, vbuf_, ks) _Pragma("unroll") for (int dt = 0; dt < 4; ++dt) dst[dt] = *(const bf16x8*)((vbuf_) + dt * 4096 + (vread ^ (unsigned)((ks) << 5)))
#define AT_VMM(src, ks) _Pragma("unroll") for (int dt = 0; dt < 4; ++dt) O[dt] = MFMA32(src[dt], pf[ks], O[dt])
#define AT_PV(vbuf_) do { \
    bf16x8 va[4], vb[4]; \
    AT_VLD(va, vbuf_, 0); AT_VLD(vb, vbuf_, 1); \
    __builtin_amdgcn_sched_barrier(0); \
    __builtin_amdgcn_s_setprio(1); \
    AT_VMM(va, 0); AT_VLD(va, vbuf_, 2); \
    __builtin_amdgcn_sched_barrier(0); \
    AT_VMM(vb, 1); AT_VLD(vb, vbuf_, 3); \
    __builtin_amdgcn_sched_barrier(0); \
    AT_VMM(va, 2); AT_VMM(vb, 3); \
    __builtin_amdgcn_s_setprio(0); } while (0)
  f32x16 S0, S1;
  bf16x8 pf[4];
  int kcur = 0;
  bool live = false, pend = false;
  __syncthreads();
  AT_STAGE(AT_K0, AT_V0, nt - 1);
  AT_STAGE(AT_K0 + 16384, AT_V0 + 16384, nt - 2);
  asm volatile("s_waitcnt vmcnt(4)" ::: "memory");
  LBAR();
  for (int it = 0; it < nt; ++it) {
    const int jt = nt - 1 - it;
    const bool first = (jt == wnt - 1);
    unsigned char* kbuf = smem + AT_K0 + kcur * 16384;
    unsigned char* vbuf = smem + AT_V0 + (it & 3) * 16384;
    const int k2 = (kcur == 0) ? 2 : kcur - 1;
    if (it + 2 < nt) AT_STAGE(AT_K0 + k2 * 16384, AT_V0 + ((it + 2) & 3) * 16384, jt - 2);
    if (mp == 0) {
      if (jt < wnt) {
        AT_QK(kbuf);
        if (jt * 64 + 63 > q0) AT_SOFTMAX(1); else AT_SOFTMAX(0);
        if (live) AT_PV(vbuf);
      }
    } else {
      if (jt < wnt) AT_QK(kbuf);
      if (pend) AT_PV(smem + AT_V0 + ((it - 1) & 3) * 16384);
      pend = false;
      if (jt < wnt) { if (jt * 64 + 63 > q0) AT_SOFTMAX(1); else AT_SOFTMAX(0); pend = live; }
    }
    kcur = (kcur == 2) ? 0 : kcur + 1;
    if (it + 2 < nt) asm volatile("s_waitcnt vmcnt(4)" ::: "memory"); else asm volatile("s_waitcnt vmcnt(0)" ::: "memory");
    LBAR();
  }
  if (mp == 1 && pend) AT_PV(smem + AT_V0 + ((nt - 1) & 3) * 16384);
  __syncthreads();
#undef AT_STAGE
#undef AT_QK
#undef AT_SOFTMAX
#undef AT_PV
#undef AT_VLD
#undef AT_VMM
  const float lt = lrun + __shfl_xor(lrun, 32);
  const float sc = (mp ? lam : 1.f) / lt;
  float* xch = (float*)(smem + qg * 16384);
  if (mp == 1) {
#pragma unroll
    for (int dt = 0; dt < 4; ++dt)
#pragma unroll
      for (int g = 0; g < 4; ++g)
        *(f32x4*)(xch + ((dt * 4 + g) * 64 + lane) * 4) = (f32x4){O[dt][4 * g] * sc, O[dt][4 * g + 1] * sc, O[dt][4 * g + 2] * sc, O[dt][4 * g + 3] * sc};
  }
  __syncthreads();
  if (mp == 0) {
    float ss = 0.f;
#pragma unroll
    for (int dt = 0; dt < 4; ++dt)
#pragma unroll
      for (int g = 0; g < 4; ++g) {
        const f32x4 o2 = *(const f32x4*)(xch + ((dt * 4 + g) * 64 + lane) * 4);
#pragma unroll
        for (int j = 0; j < 4; ++j) { const float o = O[dt][4 * g + j] * sc - o2[j]; O[dt][4 * g + j] = o; ss += o * o; }
      }
    ss += __shfl_xor(ss, 32);
    const float rn = rsqrtf(ss * (1.f / 128.f) + EPS) * 0.8f;
    const bf16_t* zp = p.proj + (tokb + iq) * NP + C_DZ + hd * 128 + 4 * hl;
    bf16_t* mo = p.mix + (tokb + iq) * 1024 + 512 + hd * 128 + 4 * hl;
    const float* gp = p.diff_gain + hd * 128 + 4 * hl;
#pragma unroll
    for (int dt = 0; dt < 4; ++dt)
#pragma unroll
      for (int g = 0; g < 4; ++g) {
        const int dv = dt * 32 + 8 * g;
        const u32x2 zz = *(const u32x2*)(zp + dv); const f32x4 gn = *(const f32x4*)(gp + dv);
        const float y0 = O[dt][4 * g + 0] * rn * gn[0] * bf_lo(zz.x), y1 = O[dt][4 * g + 1] * rn * gn[1] * bf_hi(zz.x);
        const float y2 = O[dt][4 * g + 2] * rn * gn[2] * bf_lo(zz.y), y3 = O[dt][4 * g + 3] * rn * gn[3] * bf_hi(zz.y);
        u32x2 w; w.x = pk_bf16(y0, y1); w.y = pk_bf16(y2, y3);
        *(u32x2*)(mo + dv) = w;
      }
  }
}

constexpr int GL_QIN = 0, GL_KIN = 8192, GL_KST = 16384, GL_DEC = 24576, GL_CS = 24832, GL_XST = 26880, GL_OSQ = 43264, GL_PF = 44288;
constexpr int GP_VT = 0, GP_Q = 16384, GP_K = 24576, GP_LA = 32768, GP_SZ = 49152;
DI unsigned sw128(int row, int chunk) { return (unsigned)(row * 128 + ((chunk ^ ((row >> 1) & 7)) << 4)); }

DI void gla_item(const Params& p, const int bh, unsigned char* smem, const int t) {
  const int lane = t & 63, wid = t >> 6, r32 = lane & 31, hl = lane >> 5;
  const int vt = wid & 3, kt = wid >> 2, it = kt;
  const int b = bh >> 2, hd = bh & 3;
  const size_t tokb = (size_t)b * SEQ;
  const int d = lane, jg = wid, col = hd * 64 + d;
  f32x16 St;
#pragma unroll
  for (int r = 0; r < 16; ++r) St[r] = 0.f;
  const int L0 = wid * 128 + lane, L1 = L0 + 64, vr0 = L0 >> 3, vr1 = L1 >> 3;
  const bf16_t* vg0 = p.gvT + ((size_t)bh * 128 + vr0) * SEQ + (((L0 & 7) ^ ((vr0 >> 1) & 7)) << 3);
  const bf16_t* vg1 = p.gvT + ((size_t)bh * 128 + vr1) * SEQ + (((L1 & 7) ^ ((vr1 >> 1) & 7)) << 3);
  const int Lq = wid * 64 + lane;
  const bf16_t* qg = p.proj + (tokb + (Lq >> 3)) * NP + C_GQ + hd * 64 + (Lq & 7) * 8;
  const bf16_t* kg = p.proj + (tokb + (Lq >> 3)) * NP + C_GK + hd * 64 + (Lq & 7) * 8;
  const int La0 = wid * 128 + lane, La1 = La0 + 64;
  const float* lag0 = p.la + (tokb + (La0 >> 4)) * 256 + hd * 64 + (La0 & 15) * 4;
  const float* lag1 = p.la + (tokb + (La1 >> 4)) * 256 + hd * 64 + (La1 & 15) * 4;
#define GL_STAGE(bufo, ch_) do { \
    __builtin_amdgcn_global_load_lds((const unsigned*)(vg0 + (ch_) * 64), (unsigned*)(smem + (bufo) + GP_VT + wid * 2048), 16, 0, 0); \
    __builtin_amdgcn_global_load_lds((const unsigned*)(vg1 + (ch_) * 64), (unsigned*)(smem + (bufo) + GP_VT + wid * 2048 + 1024), 16, 0, 0); \
    __builtin_amdgcn_global_load_lds((const unsigned*)(qg + (size_t)(ch_) * 64 * NP), (unsigned*)(smem + (bufo) + GP_Q + wid * 1024), 16, 0, 0); \
    __builtin_amdgcn_global_load_lds((const unsigned*)(kg + (size_t)(ch_) * 64 * NP), (unsigned*)(smem + (bufo) + GP_K + wid * 1024), 16, 0, 0); \
    __builtin_amdgcn_global_load_lds((const unsigned*)(lag0 + (size_t)(ch_) * 64 * 256), (unsigned*)(smem + (bufo) + GP_LA + wid * 2048), 16, 0, 0); \
    __builtin_amdgcn_global_load_lds((const unsigned*)(lag1 + (size_t)(ch_) * 64 * 256), (unsigned*)(smem + (bufo) + GP_LA + wid * 2048 + 1024), 16, 0, 0); } while (0)
  const int krow = swap23(r32);
  const int qi = it * 32 + r32;
  float* cs = (float*)(smem + GL_CS); float* dec = (float*)(smem + GL_DEC); float* osq = (float*)(smem + GL_OSQ);
  const int v0 = hd * 128 + vt * 32 + 4 * hl;
  f32x4 gnv[4];
#pragma unroll
  for (int g = 0; g < 4; ++g) gnv[g] = *(const f32x4*)(p.gla_gain + v0 + 8 * g);
  __syncthreads();
  GL_STAGE(GL_PF, 0);
  asm volatile("s_waitcnt vmcnt(0)" ::: "memory");
  __syncthreads();
  for (int ch = 0; ch < SEQ / 64; ++ch) {
    const size_t tok0 = tokb + (size_t)ch * 64;
    unsigned char* pb = smem + GL_PF + (ch & 1) * GP_SZ;
    if (ch + 1 < SEQ / 64) GL_STAGE(GL_PF + ((ch + 1) & 1) * GP_SZ, ch + 1);
    const bf16_t* zp = p.proj + (tok0 + qi) * NP + C_GZ + v0;
    u32x2 zz[4];
#pragma unroll
    for (int g = 0; g < 4; ++g) zz[g] = *(const u32x2*)(zp + 8 * g);
    float la[8], qv[8], kv[8];
    {
      float run = 0.f;
#pragma unroll
      for (int e = 0; e < 8; ++e) {
        const int j = jg * 8 + e;
        run += *(const float*)(pb + GP_LA + j * 256 + d * 4); la[e] = run;
        qv[e] = bf2f(*(const bf16_t*)(pb + GP_Q + j * 128 + d * 2)); kv[e] = bf2f(*(const bf16_t*)(pb + GP_K + j * 128 + d * 2));
      }
      cs[jg * 64 + d] = run;
    }
    LBAR();
    {
      float pre = 0.f, tot = 0.f;
#pragma unroll
      for (int g = 0; g < 8; ++g) { const float c = cs[g * 64 + d]; tot += c; if (g < jg) pre += c; }
      const float etot = __builtin_amdgcn_exp2f(tot * 1.44269504f);
      float ks[8];
#pragma unroll
      for (int e = 0; e < 8; ++e) {
        const int j = jg * 8 + e; const float bc = pre + la[e];
        const float eb = __builtin_amdgcn_exp2f(bc * 1.44269504f), ib = __builtin_amdgcn_rcpf(eb);
        const float qin = qv[e] * 0.125f * eb, kin = kv[e] * ib;
        ks[e] = kin * etot;
        const unsigned off = sw128(j, d >> 3) + ((d & 7) << 1);
        *(bf16_t*)(smem + GL_QIN + off) = (bf16_t)(pk_bf16(qin, 0.f) & 0xffff);
        *(bf16_t*)(smem + GL_KIN + off) = (bf16_t)(pk_bf16(kin, 0.f) & 0xffff);
      }
      u32x4 w; w.x = pk_bf16(ks[0], ks[1]); w.y = pk_bf16(ks[2], ks[3]); w.z = pk_bf16(ks[4], ks[5]); w.w = pk_bf16(ks[6], ks[7]);
      *(u32x4*)(smem + GL_KST + sw128(d, jg)) = w;
      if (jg == 0) dec[d] = etot;
      *(bf16x8*)(smem + GL_XST + ((wid * 2 + 0) * 64 + lane) * 16) = pack8(St, 0);
      *(bf16x8*)(smem + GL_XST + ((wid * 2 + 1) * 64 + lane) * 16) = pack8(St, 1);
    }
    LBAR();
    f32x16 Oacc;
#pragma unroll
    for (int r = 0; r < 16; ++r) Oacc[r] = 0.f;
#pragma unroll
    for (int js = 0; js < 2; ++js) {
      if (js > it) continue;
      f32x16 S;
#pragma unroll
      for (int r = 0; r < 16; ++r) S[r] = 0.f;
#pragma unroll
      for (int sl = 0; sl < 4; ++sl) {
        const bf16x8 af = *(const bf16x8*)(smem + GL_KIN + sw128(js * 32 + krow, sl * 2 + hl));
        const bf16x8 bq = *(const bf16x8*)(smem + GL_QIN + sw128(qi, sl * 2 + hl));
        S = MFMA32(af, bq, S);
      }
      if (js == it) {
#pragma unroll
        for (int r = 0; r < 16; ++r) { const int kof = 16 * (r >> 3) + (r & 7) + 8 * hl; if (kof > r32) S[r] = 0.f; }
      }
      const bf16x8 pf0 = pack8(S, 0), pf1 = pack8(S, 1);
      const bf16x8 va = *(const bf16x8*)(pb + GP_VT + sw128(vt * 32 + r32, js * 4 + 0 + hl));
      const bf16x8 vb = *(const bf16x8*)(pb + GP_VT + sw128(vt * 32 + r32, js * 4 + 2 + hl));
      Oacc = MFMA32(va, pf0, Oacc); Oacc = MFMA32(vb, pf1, Oacc);
    }
#pragma unroll
    for (int kk = 0; kk < 2; ++kk)
#pragma unroll
      for (int s2 = 0; s2 < 2; ++s2) {
        const bf16x8 sf = *(const bf16x8*)(smem + GL_XST + (((kk * 4 + vt) * 2 + s2) * 64 + lane) * 16);
        const bf16x8 bq = *(const bf16x8*)(smem + GL_QIN + sw128(qi, kk * 4 + s2 * 2 + hl));
        Oacc = MFMA32(sf, bq, Oacc);
      }
    {
      const float* dp = dec + kt * 32 + 8 * hl;
      const f32x4 d0 = *(const f32x4*)(dp), d1 = *(const f32x4*)(dp + 4), d2 = *(const f32x4*)(dp + 16), d3 = *(const f32x4*)(dp + 20);
#pragma unroll
      for (int j = 0; j < 4; ++j) { St[j] *= d0[j]; St[4 + j] *= d1[j]; St[8 + j] *= d2[j]; St[12 + j] *= d3[j]; }
#pragma unroll
      for (int ks = 0; ks < 4; ++ks) {
        const bf16x8 af = *(const bf16x8*)(smem + GL_KST + sw128(kt * 32 + krow, ks * 2 + hl));
        const bf16x8 bv = *(const bf16x8*)(pb + GP_VT + sw128(vt * 32 + r32, ks * 2 + hl));
        St = MFMA32(af, bv, St);
      }
    }
    {
      float ss = 0.f;
#pragma unroll
      for (int r = 0; r < 16; ++r) ss += Oacc[r] * Oacc[r];
      ss += __shfl_xor(ss, 32);
      if (hl == 0) osq[vt * 64 + qi] = ss;
    }
    asm volatile("s_waitcnt vmcnt(0)" ::: "memory");
    LBAR();
    {
      const float tot = osq[qi] + osq[64 + qi] + osq[128 + qi] + osq[192 + qi];
      const float rn = rsqrtf(tot * (1.f / 128.f) + EPS);
      bf16_t* mo = p.mix + (tok0 + qi) * 1024 + v0;
#pragma unroll
      for (int g = 0; g < 4; ++g) {
        const f32x4 gn = gnv[g];
        const float y0 = Oacc[4 * g + 0] * rn * gn[0] * bf_lo(zz[g].x), y1 = Oacc[4 * g + 1] * rn * gn[1] * bf_hi(zz[g].x);
        const float y2 = Oacc[4 * g + 2] * rn * gn[2] * bf_lo(zz[g].y), y3 = Oacc[4 * g + 3] * rn * gn[3] * bf_hi(zz[g].y);
        u32x2 w; w.x = pk_bf16(y0, y1); w.y = pk_bf16(y2, y3);
        *(u32x2*)(mo + 8 * g) = w;
      }
    }
  }
#undef GL_STAGE
}

DI void mixer_phase(const Params& p, unsigned char* smem, const int t, const int cidx = 0, const int first = 0, const int limit = 100000) {
  const float lam = lam_value(p, t);
  constexpr int N_GLA = 64, N_ATT = 64 * 16;
  volatile int* sitem = (volatile int*)(smem + LDS_BYTES - 16);
  for (;;) {
    __syncthreads();
    if (t == 0) *sitem = first + (int)atomicAdd(p.ctr + cidx, 1u);
    __syncthreads();
    const int item = *sitem;
    if (item >= N_GLA + N_ATT || item >= limit) break;
#ifndef NO_GLA
    if (item < N_GLA) gla_item(p, item, smem, fresh_tid());
#endif
#ifndef NO_ATT
    if (item >= N_GLA) { const int a = item - N_GLA; attn_item(p, a & 63, 15 - (a >> 6), lam, smem, fresh_tid()); }
#endif
  }
}

DI void final_phase(const Params& p, const int t) {
  const size_t n4 = (size_t)NTOK * 1024 / 4;
  for (size_t i = (size_t)blockIdx.x * NTHREADS + t; i < n4; i += (size_t)gridDim.x * NTHREADS) {
    const size_t row = i >> 8; const int c4 = (int)(i & 255) * 4;
    const float r = rsqrtf(p.rowsq[row] * (1.f / 1024.f) + EPS);
    const f32x4 y = *(const f32x4*)(p.out + i * 4), gv = *(const f32x4*)(p.final_gain + c4);
    *(f32x4*)(p.out + i * 4) = y * r * gv;
  }
}

typedef const __attribute__((address_space(4))) Params* ParamsK;
DI Params fresh_params() {
#if defined(__HIP_DEVICE_COMPILE__)
  ParamsK kp = (ParamsK)__builtin_amdgcn_kernarg_segment_ptr(); asm volatile("" : "+s"(kp));
  Params r; __builtin_memcpy_inline(&r, kp, sizeof(Params)); return r;
#else
  return Params{};
#endif
}

__global__ void __launch_bounds__(NTHREADS, 2) fwd_kernel(Params p_) {
  extern __shared__ __attribute__((aligned(16))) unsigned char smem[];
  cg::grid_group grid = cg::this_grid();
  const int lo = p_.phase_lo, hi = p_.phase_hi;
  if (hi == 99) grid.sync();
  volatile LAS unsigned* st = (volatile LAS unsigned*)(smem + LDS_BYTES - 32);
  if (lo < hi) {
    if (threadIdx.x == 0) { st[0] = 0u; st[1] = 0u; (void)xb_add(&p_.bar[XB_XCNT(xb_xcc_id())], 1u); }
    __syncthreads();
  }
#define SEAM(a_) do { if (lo <= (a_) && (a_) + 1 <= hi) { const Params pb = fresh_params(); xcd_barrier(pb.bar, st); } } while (0)
#ifndef PHM
#define PHM 63
#endif
  if ((PHM & 1) && lo <= 0 && 0 <= hi) { const Params p = fresh_params(); phase0a(p, smem, fresh_tid()); }
  SEAM(0);
  if ((PHM & 2) && lo <= 1 && 1 <= hi) { const Params p = fresh_params(); phase0b(p, smem, fresh_tid()); }
  SEAM(1);
  if ((PHM & 4) && lo <= 2 && 2 <= hi) { const Params p = fresh_params(); gemm1_phase(p); }
  SEAM(2);
  if ((PHM & 8) && lo <= 3 && 3 <= hi) { const Params p = fresh_params(); mixer_phase(p, smem, fresh_tid()); }
  SEAM(3);
  if ((PHM & 16) && lo <= 4 && 4 <= hi) { const Params p = fresh_params(); gemm2_phase(p); }
}

extern "C" void kernel_launch(void* const* d_in, const int* in_sizes, int n_in, void* d_out, int out_size, void* d_ws, size_t ws_size, hipStream_t stream) {
  static int grid_blocks = 0;
  if (!grid_blocks) {
    hipFuncSetAttribute((const void*)fwd_kernel, hipFuncAttributeMaxDynamicSharedMemorySize, LDS_BYTES);
    int dev = 0, cus = 0, per_cu = 0;
    hipGetDevice(&dev);
    hipDeviceGetAttribute(&cus, hipDeviceAttributeMultiprocessorCount, dev);
    hipOccupancyMaxActiveBlocksPerMultiprocessor(&per_cu, fwd_kernel, NTHREADS, LDS_BYTES);
    if (per_cu < 1) per_cu = 1;
    grid_blocks = cus * per_cu;
  }
  Params p{};
  p.x = (const float*)d_in[0]; p.c = (const float*)d_in[1]; p.w_ada = (const float*)d_in[2]; p.b_ada = (const float*)d_in[3];
  p.norm_gain = (const float*)d_in[4]; p.w_in = (const float*)d_in[5]; p.w_up = (const float*)d_in[6]; p.b_gate = (const float*)d_in[7];
  p.gla_gain = (const float*)d_in[8]; p.lq1 = (const float*)d_in[9]; p.lk1 = (const float*)d_in[10]; p.lq2 = (const float*)d_in[11];
  p.lk2 = (const float*)d_in[12]; p.diff_gain = (const float*)d_in[13]; p.w_out = (const float*)d_in[14]; p.final_gain = (const float*)d_in[15];
  p.out = (float*)d_out;
  unsigned char* w = (unsigned char*)d_ws; size_t off = 0;
  auto take = [&](size_t bytes) { void* r = w + off; off += (bytes + 255) & ~(size_t)255; return r; };
  p.modpart = (float*)take((size_t)8 * 16 * 3072 * 4);
  p.mod = (float*)take((size_t)16 * 3072 * 4);
  p.rowsq = (float*)take((size_t)NTOK * 4);
  p.la = (float*)take((size_t)NTOK * 256 * 4);
  p.winT = (bf16_t*)take((size_t)NP * 1024 * 2);
  p.woutT = (bf16_t*)take((size_t)1024 * 1024 * 2);
  p.h = (bf16_t*)take((size_t)NTOK * 1024 * 2);
  p.proj = (bf16_t*)take((size_t)NTOK * NP * 2);
  p.mix = (bf16_t*)take((size_t)NTOK * 1024 * 2);
  p.gvT = (bf16_t*)take((size_t)NTOK * 512 * 2);
  p.dvT = (bf16_t*)take((size_t)NTOK * 512 * 2);
  p.bar = (unsigned*)take((size_t)XCD_BAR_WORDS * 4 + 1024);
  p.ctr = p.bar + XCD_BAR_WORDS;
  p.pcnt = p.ctr + 64;
#if 0
  hipMemsetAsync(p.bar, 0, (size_t)XCD_BAR_WORDS * 4 + 1024, stream);
  for (int ph = 0; ph < 5; ++ph) {
    p.phase_lo = ph; p.phase_hi = ph;
    hipLaunchKernelGGL(fwd_kernel, dim3(grid_blocks), dim3(NTHREADS), LDS_BYTES, stream, p);
  }
#else
  p.phase_lo = 0; p.phase_hi = 4;
  hipMemsetAsync(p.bar, 0, (size_t)XCD_BAR_WORDS * 4 + 1024, stream);
  void* args[] = {&p};
  hipError_t e = hipLaunchCooperativeKernel((void*)fwd_kernel, dim3(grid_blocks), dim3(NTHREADS), args, LDS_BYTES, stream);
  if (e != hipSuccess) fprintf(stderr, "cooperative launch failed: %s (grid %d)\n", hipGetErrorString(e), grid_blocks);
#endif
}
```

```cpp
#include <hip/hip_runtime.h>
#include <hip/hip_cooperative_groups.h>
#include <cstdio>
#include <cstdint>
namespace cg = cooperative_groups;

typedef unsigned short bf16_t;
typedef short bf16x8 __attribute__((ext_vector_type(8)));
typedef float f32x4 __attribute__((ext_vector_type(4)));
typedef float f32x2 __attribute__((ext_vector_type(2)));
typedef __bf16 bf16v2 __attribute__((ext_vector_type(2)));
typedef unsigned u32x4 __attribute__((ext_vector_type(4)));
typedef unsigned u32x2 __attribute__((ext_vector_type(2)));

#define DI __device__ __forceinline__

constexpr int D_MODEL = 1024, BATCH = 16, SEQ = 2048, NTOK = BATCH * SEQ;
constexpr int D_IN = 3600, NP = 3584;
constexpr int C_GQ = 0, C_GK = 256, C_GV = 512, C_GZ = 1024, C_DQ = 1536, C_DK = 2048, C_DV = 2560, C_DZ = 3072;
constexpr int NTHREADS = 512;
constexpr int LDS_BYTES = 147456;
constexpr float EPS = 1e-6f;

struct Params {
  const float *x, *c, *w_ada, *b_ada, *norm_gain, *w_in, *w_up, *b_gate, *gla_gain, *lq1, *lk1, *lq2, *lk2, *diff_gain, *w_out, *final_gain;
  float* out;
  float* modpart;
  float* mod;
  float* rowsq;
  float* la;
  bf16_t* winT;
  bf16_t* woutT;
  bf16_t* h;
  bf16_t* proj;
  bf16_t* mix;
  bf16_t* gvT;
  bf16_t* dvT;
  unsigned* ctr;
  unsigned* bar;
  unsigned* pcnt;
  int phase_lo, phase_hi;
};

DI unsigned pk_bf16(float a, float b) { f32x2 v = {a, b}; bf16v2 r = __builtin_convertvector(v, bf16v2); return __builtin_bit_cast(unsigned, r); }
DI float bf_lo(unsigned u) { return __uint_as_float(u << 16); }
DI float bf_hi(unsigned u) { return __uint_as_float(u & 0xffff0000u); }
DI float bf2f(bf16_t u) { return __uint_as_float(((unsigned)u) << 16); }
DI float wave_sum(float v) {
#pragma unroll
  for (int o = 32; o >= 1; o >>= 1) v += __shfl_xor(v, o);
  return v;
}
DI float wave_max(float v) {
#pragma unroll
  for (int o = 32; o >= 1; o >>= 1) v = fmaxf(v, __shfl_xor(v, o));
  return v;
}
DI void swap32(unsigned& a, unsigned& b) { auto r = __builtin_amdgcn_permlane32_swap(a, b, false, false); a = r[0]; b = r[1]; }
DI float silu_f(float v) { return v * __builtin_amdgcn_rcpf(1.f + __builtin_amdgcn_exp2f(-1.44269504f * v)); }

#define XB_TMO      128
#define XB_XCNT(j)  (256  + 64 * (j))
#define XB_XSUB(j)  (1280 + 64 * (j))
#define XB_XGEN(j)  (2304 + 64 * (j))
#define XB_TOP      3328
#define XB_TOPGEN   3392
#define XCD_BAR_WORDS 3456
#define XB_SPIN_CAP (1u << 20)
#define LAS __attribute__((address_space(3)))
DI unsigned xb_ld(unsigned* p)              { return __hip_atomic_load(p, __ATOMIC_RELAXED, __HIP_MEMORY_SCOPE_AGENT); }
DI unsigned xb_add(unsigned* p, unsigned v) { return __hip_atomic_fetch_add(p, v, __ATOMIC_RELAXED, __HIP_MEMORY_SCOPE_AGENT); }
DI unsigned xb_xcc_id() { return (unsigned)__builtin_amdgcn_s_getreg((3 << 11) | 20) & 0xFu; }
#define XB_SPIN(cond, bar) do { unsigned _sp = 0; while (cond) { __builtin_amdgcn_s_sleep(1); \
    if ((++_sp & 255u) == 0u) { if (xb_ld(&(bar)[XB_TMO])) break; if (_sp > XB_SPIN_CAP) { atomicAdd(&(bar)[XB_TMO], 1u); break; } } } } while (0)
DI void xcd_barrier_complete(unsigned* bar, unsigned x, unsigned& nloc, unsigned& nx) {
  const unsigned G = gridDim.x;
  unsigned sum, cnt, mine, sp = 0u;
  for (;;) {
    sum = 0u; cnt = 0u; mine = 0u;
#pragma unroll
    for (unsigned j = 0; j < 16; ++j) { const unsigned c = xb_ld(&bar[XB_XCNT(j)]); sum += c; cnt += (c > 0u) ? 1u : 0u; mine = (j == x) ? c : mine; }
    if (sum == G) break;
    __builtin_amdgcn_s_sleep(1);
    if ((++sp & 255u) == 0u) { if (xb_ld(&bar[XB_TMO])) break; if (sp > XB_SPIN_CAP) { atomicAdd(&bar[XB_TMO], 1u); break; } }
  }
  nloc = mine > 0u ? mine : 1u; nx = cnt > 0u ? cnt : 1u;
}
DI void xcd_barrier(unsigned* bar, volatile LAS unsigned* st) {
  asm volatile("s_waitcnt vmcnt(0)" ::: "memory");
  __syncthreads();
  if (threadIdx.x == 0) {
    const unsigned x = xb_xcc_id();
    __builtin_amdgcn_s_waitcnt(0);
    unsigned nloc = st[0], nx = st[1];
    if (nloc == 0u) { xcd_barrier_complete(bar, x, nloc, nx); st[0] = nloc; st[1] = nx; }
    const unsigned old = xb_add(&bar[XB_XSUB(x)], 1u);
    const unsigned gen = old / nloc;
    if (old + 1u == (gen + 1u) * nloc) {
      __builtin_amdgcn_fence(__ATOMIC_RELEASE, "agent");
      asm volatile("s_waitcnt vmcnt(0)" ::: "memory");
      const unsigned og = xb_add(&bar[XB_TOP], 1u);
      const unsigned tg = og / nx;
      if (og + 1u == (tg + 1u) * nx) xb_add(&bar[XB_TOPGEN], 1u);
      else XB_SPIN(xb_ld(&bar[XB_TOPGEN]) == tg, bar);
      __builtin_amdgcn_fence(__ATOMIC_ACQUIRE, "agent");
      xb_add(&bar[XB_XGEN(x)], 1u);
      asm volatile("s_waitcnt vmcnt(0)" ::: "memory");
    } else {
      XB_SPIN(xb_ld(&bar[XB_XGEN(x)]) == gen, bar);
      __builtin_amdgcn_fence(__ATOMIC_ACQUIRE, "agent");
      asm volatile("s_waitcnt vmcnt(0)" ::: "memory");
    }
  }
  __syncthreads();
}

DI int fresh_tid() { int t = threadIdx.x; asm volatile("" : "+v"(t)); return t; }

DI int perm32(int r) { return 8 * ((r & 15) >> 2) + 4 * (r >> 4) + (r & 3); }
DI int inv32(int a) { return ((a >> 2) & 1) * 16 + (a >> 3) * 4 + (a & 3); }

DI void phase0a(const Params& p, unsigned char* smem, const int t) {
  for (int i = blockIdx.x * NTHREADS + t; i < NTOK; i += gridDim.x * NTHREADS) p.rowsq[i] = 0.f;
  constexpr int N_MOD = 192, N_WIN = 16 * 56, N_WOUT = 16 * 16;
  for (int item = blockIdx.x; item < N_MOD + N_WIN + N_WOUT; item += gridDim.x) {
    __syncthreads();
    if (item < N_MOD) {
      const int nc = item % 24, ks = item / 24, n0 = nc * 128, k0 = ks * 128;
      float* sc = (float*)smem;
      float* red = sc + 16 * 128;
      for (int e = t; e < 2048; e += NTHREADS) { const int b = e >> 7, kk = e & 127; sc[e] = silu_f(p.c[b * 1024 + k0 + kk]); }
      __syncthreads();
      const int nl = t & 127, sub = t >> 7;
      float acc[16];
#pragma unroll
      for (int b = 0; b < 16; ++b) acc[b] = 0.f;
      for (int kk = sub * 32; kk < sub * 32 + 32; ++kk) {
        const float w = __builtin_nontemporal_load(p.w_ada + (size_t)(k0 + kk) * 3072 + n0 + nl);
#pragma unroll
        for (int b = 0; b < 16; ++b) acc[b] += sc[b * 128 + kk] * w;
      }
#pragma unroll
      for (int b = 0; b < 16; ++b) red[(sub * 16 + b) * 128 + nl] = acc[b];
      __syncthreads();
      for (int e = t; e < 2048; e += NTHREADS) {
        const int b = e >> 7, n = e & 127;
        p.modpart[((size_t)ks * 16 + b) * 3072 + n0 + n] = red[(0 * 16 + b) * 128 + n] + red[(1 * 16 + b) * 128 + n] + red[(2 * 16 + b) * 128 + n] + red[(3 * 16 + b) * 128 + n];
      }
    } else {
      const float* src; bf16_t* dst; int ld, k0, n0, ncol;
      if (item < N_MOD + N_WIN) { const int it = item - N_MOD; k0 = (it % 16) * 64; n0 = (it / 16) * 64; src = p.w_in; ld = D_IN; dst = p.winT; ncol = n0 < C_DQ ? n0 : n0 + 16; }
      else { const int it = item - N_MOD - N_WIN; k0 = (it % 16) * 64; n0 = (it / 16) * 64; src = p.w_out; ld = 1024; dst = p.woutT; ncol = n0; }
      float* tile = (float*)smem;
#pragma unroll
      for (int e = 0; e < 8; ++e) { const int idx = e * NTHREADS + t, r = idx >> 6, cc = idx & 63; tile[r * 65 + cc] = __builtin_nontemporal_load(src + (size_t)(k0 + r) * ld + ncol + cc); }
      __syncthreads();
      const int n = t >> 3, ksg = (t & 7) * 8;
      const int ns = (src == p.w_in) ? ((n & ~31) | perm32(n & 31)) : n;
      u32x4 w;
      w.x = pk_bf16(tile[(ksg + 0) * 65 + ns], tile[(ksg + 1) * 65 + ns]);
      w.y = pk_bf16(tile[(ksg + 2) * 65 + ns], tile[(ksg + 3) * 65 + ns]);
      w.z = pk_bf16(tile[(ksg + 4) * 65 + ns], tile[(ksg + 5) * 65 + ns]);
      w.w = pk_bf16(tile[(ksg + 6) * 65 + ns], tile[(ksg + 7) * 65 + ns]);
      *(u32x4*)(dst + (size_t)(n0 + n) * 1024 + k0 + ksg) = w;
    }
  }
}

DI void phase0b(const Params& p, unsigned char* smem, const int t) {
  const int lane = t & 63, wid = t >> 6;
  for (int i = blockIdx.x * NTHREADS + t; i < 16 * 3072; i += gridDim.x * NTHREADS) {
    float s = p.b_ada[i % 3072];
#pragma unroll
    for (int ks = 0; ks < 8; ++ks) s += p.modpart[(size_t)ks * 16 * 3072 + i];
    p.mod[i] = s;
  }
  float* g = (float*)smem;
  float* sh = g + 1024;
  float* wg = sh + 1024;
  f32x4 wup[16];
#pragma unroll
  for (int r = 0; r < 16; ++r) wup[r] = *(const f32x4*)(p.w_up + r * 256 + lane * 4);
  const f32x4 bgv = *(const f32x4*)(p.b_gate + lane * 4);
  for (int item = blockIdx.x; item < NTOK / 128; item += gridDim.x) {
    const int b = item / 16, row0 = item * 128;
    __syncthreads();
    for (int k = t; k < 1024; k += NTHREADS) {
      float s_sh = p.b_ada[k], s_sc = p.b_ada[1024 + k];
#pragma unroll
      for (int ks = 0; ks < 8; ++ks) { s_sh += p.modpart[((size_t)ks * 16 + b) * 3072 + k]; s_sc += p.modpart[((size_t)ks * 16 + b) * 3072 + 1024 + k]; }
      g[k] = p.norm_gain[k] * (1.f + s_sc); sh[k] = s_sh;
    }
    for (int e = t; e < 4096; e += NTHREADS) {
      const int r = e & 15, L = (e >> 4) & 63, i = e >> 10, k = i * 256 + 4 * L;
      const float* wp = p.w_in + (size_t)k * D_IN + 1536 + r;
      u32x2 w; w.x = pk_bf16(wp[0], wp[D_IN]); w.y = pk_bf16(wp[2 * D_IN], wp[3 * D_IN]);
      *(u32x2*)((unsigned char*)wg + (i * 64 + L) * 128 + (((r >> 1) ^ ((L >> 1) & 7)) << 4) + (r & 1) * 8) = w;
    }
    __syncthreads();
    f32x4 xn[4];
#pragma unroll
    for (int i = 0; i < 4; ++i) xn[i] = __builtin_nontemporal_load((const f32x4*)(p.x + (size_t)(row0 + wid) * 1024 + i * 256 + lane * 4));
    for (int rr = wid; rr < 128; rr += 8) {
      const size_t row = row0 + rr;
      const size_t hrow = (row & ~(size_t)31) | (size_t)inv32((int)(row & 31));
      f32x4 xv[4];
#pragma unroll
      for (int i = 0; i < 4; ++i) xv[i] = xn[i];
      if (rr + 8 < 128) {
#pragma unroll
        for (int i = 0; i < 4; ++i) xn[i] = __builtin_nontemporal_load((const f32x4*)(p.x + (row + 8) * 1024 + i * 256 + lane * 4));
      }
      float ss = 0.f;
#pragma unroll
      for (int i = 0; i < 4; ++i) ss += xv[i][0] * xv[i][0] + xv[i][1] * xv[i][1] + xv[i][2] * xv[i][2] + xv[i][3] * xv[i][3];
      ss = wave_sum(ss);
      const float rstd = rsqrtf(ss * (1.f / 1024.f) + EPS);
      float pr[16];
#pragma unroll
      for (int r = 0; r < 16; ++r) pr[r] = 0.f;
#pragma unroll
      for (int i = 0; i < 4; ++i) {
        const int k = i * 256 + lane * 4;
        const f32x4 gv = *(const f32x4*)(g + k), sv = *(const f32x4*)(sh + k);
        const f32x4 hv = xv[i] * rstd * gv + sv;
        u32x2 w; w.x = pk_bf16(hv[0], hv[1]); w.y = pk_bf16(hv[2], hv[3]);
        *(u32x2*)(p.h + hrow * 1024 + k) = w;
        const unsigned char* wrow = (const unsigned char*)wg + (i * 64 + lane) * 128;
#pragma unroll
        for (int c = 0; c < 8; ++c) {
          const u32x4 wv = *(const u32x4*)(wrow + ((c ^ ((lane >> 1) & 7)) << 4));
          asm volatile("v_dot2c_f32_bf16 %0, %1, %2" : "+v"(pr[2 * c]) : "v"(w.x), "v"(wv.x));
          asm volatile("v_dot2c_f32_bf16 %0, %1, %2" : "+v"(pr[2 * c]) : "v"(w.y), "v"(wv.y));
          asm volatile("v_dot2c_f32_bf16 %0, %1, %2" : "+v"(pr[2 * c + 1]) : "v"(w.x), "v"(wv.z));
          asm volatile("v_dot2c_f32_bf16 %0, %1, %2" : "+v"(pr[2 * c + 1]) : "v"(w.y), "v"(wv.w));
        }
        __builtin_amdgcn_sched_barrier(0);
      }
      float a8[8], a4[4], a2[2], a1;
      { const bool hi = lane & 1;
#pragma unroll
        for (int i = 0; i < 8; ++i) { const float keep = hi ? pr[i + 8] : pr[i], send = hi ? pr[i] : pr[i + 8]; a8[i] = keep + __shfl_xor(send, 1); } }
      { const bool hi = lane & 2;
#pragma unroll
        for (int i = 0; i < 4; ++i) { const float keep = hi ? a8[i + 4] : a8[i], send = hi ? a8[i] : a8[i + 4]; a4[i] = keep + __shfl_xor(send, 2); } }
      { const bool hi = lane & 4;
#pragma unroll
        for (int i = 0; i < 2; ++i) { const float keep = hi ? a4[i + 2] : a4[i], send = hi ? a4[i] : a4[i + 2]; a2[i] = keep + __shfl_xor(send, 4); } }
      { const bool hi = lane & 8; const float keep = hi ? a2[1] : a2[0], send = hi ? a2[0] : a2[1]; a1 = keep + __shfl_xor(send, 8); }
      a1 += __shfl_xor(a1, 16); a1 += __shfl_xor(a1, 32);
      float* grs = (float*)(smem + 73728) + wid * 16;
      if (lane < 16) grs[8 * (lane & 1) + 4 * ((lane >> 1) & 1) + 2 * ((lane >> 2) & 1) + ((lane >> 3) & 1)] = a1;
      const f32x4 g0 = *(const f32x4*)(grs), g1 = *(const f32x4*)(grs + 4), g2 = *(const f32x4*)(grs + 8), g3 = *(const f32x4*)(grs + 12);
      f32x4 lg = bgv;
#pragma unroll
      for (int j = 0; j < 4; ++j) {
        lg += g0[j] * wup[j] + g1[j] * wup[4 + j] + g2[j] * wup[8 + j] + g3[j] * wup[12 + j];
      }
      f32x4 lav;
#pragma unroll
      for (int j = 0; j < 4; ++j) lav[j] = (fminf(lg[j], 0.f) - __logf(1.f + __expf(-fabsf(lg[j])))) * (1.f / 16.f);
      __builtin_nontemporal_store(lav, (f32x4*)(p.la + row * 256 + lane * 4));
    }
  }
}

constexpr int BM = 256, BK = 64, HALF = 128, NXCD = 8, WGM = 8, HT = HALF * BK;
DI int lds_byte(int r, int c) { int st = (r >> 4) * 2 + (c >> 5), rr = r & 15, cc = c & 31, ob = rr * 64 + cc * 2; return st * 1024 + (ob ^ (((ob >> 9) & 1) << 5)); }
DI void stage_rc(int b, int& R, int& C) { int st = b / 1024, sb = b % 1024, swz = sb ^ (((sb >> 9) & 1) << 5); R = (st >> 1) * 16 + swz / 64; C = (st & 1) * 32 + (swz % 64) / 2; }

template <class Epi>
DI void gemm_tile(const bf16_t* __restrict__ A, const bf16_t* __restrict__ Bt, const int K, const int brow, const int bcol, const Epi& epi) {
  extern __shared__ __attribute__((aligned(16))) unsigned char smem[];
  bf16_t* shm = (bf16_t*)smem;
#define SA(b, h) (shm + ((b) * 2 + (h)) * HT)
#define SB(b, h) (shm + (4 + (b) * 2 + (h)) * HT)
#define STAGE(P, BASE, br, kt) do { const bf16_t* _gb = (BASE) + ((long)(br) * K + (long)(kt) * BK); \
    __builtin_amdgcn_global_load_lds((const unsigned*)(_gb + toff0), (unsigned*)((char*)(P) + tb16), 16, 0, 0); \
    __builtin_amdgcn_global_load_lds((const unsigned*)(_gb + toff1), (unsigned*)((char*)(P) + tb16 + 8192), 16, 0, 0); } while (0)
#define LDA(dst, b, h) for (int m = 0; m < 4; ++m) for (int k = 0; k < 2; ++k) \
    dst[m][k] = *reinterpret_cast<const bf16x8*>(smem + a_base_ + (((b) * 2 + (h)) * 16384 + m * 2048 + k * 1024))
#define LDB(dst, b, h) for (int n = 0; n < 2; ++n) for (int k = 0; k < 2; ++k) \
    dst[n][k] = *reinterpret_cast<const bf16x8*>(smem + b_base_ + (((b) * 2 + (h)) * 16384 + n * 2048 + k * 1024))
#define MMA(ai, bj, At, Bt_) do { __builtin_amdgcn_s_setprio(1); \
    for (int m = 0; m < 4; ++m) for (int n = 0; n < 2; ++n) for (int k = 0; k < 2; ++k) \
      acc[ai][bj][m][n] = __builtin_amdgcn_mfma_f32_16x16x32_bf16(Bt_[n][k], At[m][k], acc[ai][bj][m][n], 0, 0, 0); \
    __builtin_amdgcn_s_setprio(0); } while (0)
#define WAIT_V(n) asm volatile("s_waitcnt vmcnt(" #n ")" ::: "memory")
#define WAIT_L(n) asm volatile("s_waitcnt lgkmcnt(" #n ")" ::: "memory")
#define BAR __builtin_amdgcn_s_barrier()
#define SCHED __builtin_amdgcn_sched_barrier(0)
  const int tid = fresh_tid();
  const int wid = tid >> 6, lane = tid & 63, wr = wid >> 2, wc = wid & 3, fr = lane & 15, fq = lane >> 4;
  const int tb16 = tid * 16;
  const unsigned a_base = (unsigned)lds_byte(wr * 64 + fr, fq * 8), b_base = 65536u + (unsigned)lds_byte(wc * 32 + fr, fq * 8);
  unsigned a_base_ = a_base, b_base_ = b_base; asm volatile("" : "+v"(a_base_), "+v"(b_base_));
  unsigned toff0, toff1;
  { int r0, c0, r1, c1; stage_rc(tb16, r0, c0); stage_rc(tb16 + 8192, r1, c1); toff0 = (unsigned)(r0 * K + c0); toff1 = (unsigned)(r1 * K + c1); }
  f32x4 acc[2][2][4][2] = {};
  bf16x8 At[4][2], B0[2][2], B1[2][2];
  const int nt = K / BK;
  STAGE(SB(0, 0), Bt, bcol, 0); STAGE(SA(0, 0), A, brow, 0);
  STAGE(SB(0, 1), Bt, bcol + HALF, 0); STAGE(SA(0, 1), A, brow + HALF, 0);
  if (wr == 1) BAR;
  WAIT_V(4); BAR;
  STAGE(SB(1, 0), Bt, bcol, 1); STAGE(SA(1, 0), A, brow, 1); STAGE(SB(1, 1), Bt, bcol + HALF, 1);
  WAIT_V(6); BAR;
  for (int t = 0; t < nt - 2; t += 2) {
    LDB(B0, 0, 0); SCHED; LDA(At, 0, 0); STAGE(SA(1, 1), A, brow + HALF, t + 1);
    WAIT_L(8); BAR; WAIT_L(0); MMA(0, 0, At, B0); BAR; SCHED;
    LDB(B1, 0, 1); STAGE(SB(0, 0), Bt, bcol, t + 2);
    BAR; WAIT_L(0); MMA(0, 1, At, B1); BAR;
    LDA(At, 0, 1); STAGE(SA(0, 0), A, brow, t + 2);
    BAR; WAIT_L(0); MMA(1, 0, At, B0); BAR; SCHED;
    STAGE(SB(0, 1), Bt, bcol + HALF, t + 2);
    WAIT_V(6); BAR; MMA(1, 1, At, B1); BAR;
    LDB(B0, 1, 0); SCHED; LDA(At, 1, 0); STAGE(SA(0, 1), A, brow + HALF, t + 2);
    WAIT_L(8); BAR; WAIT_L(0); MMA(0, 0, At, B0); BAR; SCHED;
    LDB(B1, 1, 1); STAGE(SB(1, 0), Bt, bcol, t + 3);
    BAR; WAIT_L(0); MMA(0, 1, At, B1); BAR;
    LDA(At, 1, 1); STAGE(SA(1, 0), A, brow, t + 3);
    BAR; WAIT_L(0); MMA(1, 0, At, B0); BAR; SCHED;
    STAGE(SB(1, 1), Bt, bcol + HALF, t + 3);
    WAIT_V(6); BAR; MMA(1, 1, At, B1); BAR;
  }
  { LDB(B0, 0, 0); LDA(At, 0, 0); STAGE(SA(1, 1), A, brow + HALF, nt - 1);
    BAR; WAIT_L(0); MMA(0, 0, At, B0); BAR;
    LDB(B1, 0, 1); BAR; WAIT_L(0); MMA(0, 1, At, B1); BAR;
    LDA(At, 0, 1); WAIT_V(4); BAR; WAIT_L(0); MMA(1, 0, At, B0); MMA(1, 1, At, B1); BAR; }
  { LDB(B0, 1, 0); LDA(At, 1, 0); WAIT_V(2); BAR; WAIT_L(0); MMA(0, 0, At, B0); BAR;
    LDB(B1, 1, 1); WAIT_V(0); BAR; WAIT_L(0); MMA(0, 1, At, B1); BAR;
    LDA(At, 1, 1); BAR; WAIT_L(0); MMA(1, 0, At, B0); MMA(1, 1, At, B1); BAR; }
  if (wr == 0) BAR;
  { int tid2 = threadIdx.x; asm volatile("" : "+v"(tid2));
    const int wid2 = tid2 >> 6, lane2 = tid2 & 63;
    epi(acc, brow, bcol, (wid2 >> 2) * 64, lane2 & 15, (wid2 & 3) * 32 + (lane2 >> 4) * 8, lane2); }
#undef SA
#undef SB
#undef STAGE
#undef LDA
#undef LDB
#undef MMA
}

DI bool tile_order(int i, int G, int c, int nM, int nN, int& pm, int& pn) {
  const int nwg = nM * nN; const long L = (long)i * G + c; if (L >= nwg) return false;
  int wgid = (int)L; { const int q = nwg / NXCD, r = nwg % NXCD, xcd = wgid % NXCD, off = wgid / NXCD; wgid = (xcd < r ? xcd * (q + 1) : r * (q + 1) + (xcd - r) * q) + off; }
  const int nig = WGM * nN, gid = wgid / nig, fm = gid * WGM, gsz = (nM - fm) < WGM ? (nM - fm) : WGM;
  pm = fm + ((wgid % nig) % gsz); pn = (wgid % nig) / gsz; return true;
}

struct EpiProj {
  bf16_t* O; bf16_t* gvT; bf16_t* dvT; int vmode;
  DI void operator()(f32x4 (&acc)[2][2][4][2], int brow, int bcol, int rw, int fr, int cw, int lane) const {
    const int rperm = 8 * (fr >> 2) + (fr & 3);
    if (vmode == 0) {
      const bool sil = (bcol >= C_GZ && bcol < C_DQ) || (bcol >= C_DZ);
#pragma unroll
      for (int ai = 0; ai < 2; ++ai)
#pragma unroll
        for (int m = 0; m < 4; ++m) {
          const int row = brow + ai * HALF + rw + (m >> 1) * 32 + 4 * (m & 1) + rperm;
          bf16_t* rp = O + (size_t)row * NP + bcol + cw;
#pragma unroll
          for (int bj = 0; bj < 2; ++bj) {
            f32x4 v0 = acc[ai][bj][m][0], v1 = acc[ai][bj][m][1];
            if (sil) {
#pragma unroll
              for (int j = 0; j < 4; ++j) { v0[j] = silu_f(v0[j]); v1[j] = silu_f(v1[j]); }
            }
            u32x4 w; w.x = pk_bf16(v0[0], v0[1]); w.y = pk_bf16(v0[2], v0[3]); w.z = pk_bf16(v1[0], v1[1]); w.w = pk_bf16(v1[2], v1[3]);
            *(u32x4*)(rp + bj * HALF) = w;
          }
        }
    } else {
      bf16_t* T = (vmode == 1) ? gvT : dvT;
      const int vbase = brow - ((vmode == 1) ? C_GV : C_DV);
      const int b = bcol / SEQ, s0 = bcol % SEQ + cw;
#pragma unroll
      for (int ai = 0; ai < 2; ++ai)
#pragma unroll
        for (int m = 0; m < 4; ++m) {
          const int v = vbase + ai * HALF + rw + (m >> 1) * 32 + 4 * (m & 1) + rperm;
          bf16_t* rp = T + ((size_t)b * 512 + v) * SEQ + s0;
#pragma unroll
          for (int bj = 0; bj < 2; ++bj) {
            const f32x4 v0 = acc[ai][bj][m][0], v1 = acc[ai][bj][m][1];
            u32x4 w; w.x = pk_bf16(v0[0], v0[1]); w.y = pk_bf16(v0[2], v0[3]); w.z = pk_bf16(v1[0], v1[1]); w.w = pk_bf16(v1[2], v1[3]);
            *(u32x4*)(rp + bj * HALF) = w;
          }
        }
    }
  }
};
struct EpiOut {
  const float* x; const float* mod; const float* fgain; float* out; float* rowsq; unsigned* pcnt;
  DI void operator()(f32x4 (&acc)[2][2][4][2], int brow, int bcol, int rw, int fr, int cwp, int lane) const {
    extern __shared__ __attribute__((aligned(16))) unsigned char smem[];
    constexpr int TS = 1040;
    const int b = brow / SEQ, wid = threadIdx.x >> 6;
    const int cw = (cwp & ~31) + ((cwp & 31) >> 1);
    f32x4 gt[2][2];
#pragma unroll
    for (int bj = 0; bj < 2; ++bj)
#pragma unroll
      for (int n = 0; n < 2; ++n) gt[bj][n] = *(const f32x4*)(mod + (size_t)b * 3072 + 2048 + bcol + cw + bj * HALF + n * 16);
    f32x4 Y[2][16];
    float myss[2] = {0.f, 0.f};
    __syncthreads();
#pragma unroll
    for (int ai = 0; ai < 2; ++ai) {
      const float* xb = x + (size_t)(brow + ai * HALF + wid * 16) * 1024 + bcol + lane * 4;
#pragma unroll
      for (int i = 0; i < 16; ++i) Y[ai][i] = __builtin_nontemporal_load((const f32x4*)(xb + (size_t)i * 1024));
#pragma unroll
      for (int m = 0; m < 4; ++m)
#pragma unroll
        for (int bj = 0; bj < 2; ++bj)
#pragma unroll
          for (int n = 0; n < 2; ++n)
            *(f32x4*)(smem + (rw + m * 16 + fr) * TS + (bj * HALF + cw + n * 16) * 4) = gt[bj][n] * acc[ai][bj][m][n];
      __syncthreads();
#pragma unroll
      for (int i = 0; i < 16; ++i) {
        const f32x4 v = *(const f32x4*)(smem + (wid * 16 + i) * TS + lane * 16);
        const f32x4 y = Y[ai][i] + v; Y[ai][i] = y;
        const float ss = wave_sum(y[0] * y[0] + y[1] * y[1] + y[2] * y[2] + y[3] * y[3]);
        if (lane == i) myss[ai] = ss;
      }
      __syncthreads();
    }
    if (lane < 16) {
      (void)__hip_atomic_fetch_add(rowsq + (size_t)(brow + wid * 16 + lane), myss[0], __ATOMIC_RELAXED, __HIP_MEMORY_SCOPE_AGENT);
      (void)__hip_atomic_fetch_add(rowsq + (size_t)(brow + HALF + wid * 16 + lane), myss[1], __ATOMIC_RELAXED, __HIP_MEMORY_SCOPE_AGENT);
    }
    asm volatile("s_waitcnt vmcnt(0)" ::: "memory");
    __syncthreads();
    if (threadIdx.x == 0) {
      unsigned* c = pcnt + (brow >> 8);
      (void)__hip_atomic_fetch_add(c, 1u, __ATOMIC_RELAXED, __HIP_MEMORY_SCOPE_AGENT);
      unsigned sp = 0;
      while (__hip_atomic_load(c, __ATOMIC_RELAXED, __HIP_MEMORY_SCOPE_AGENT) < 4u) { __builtin_amdgcn_s_sleep(1); if (++sp > (1u << 22)) break; }
    }
    __syncthreads();
    float rn[2] = {0.f, 0.f};
    if (lane < 16) {
      rn[0] = rsqrtf(__hip_atomic_load(rowsq + (size_t)(brow + wid * 16 + lane), __ATOMIC_RELAXED, __HIP_MEMORY_SCOPE_AGENT) * (1.f / 1024.f) + EPS);
      rn[1] = rsqrtf(__hip_atomic_load(rowsq + (size_t)(brow + HALF + wid * 16 + lane), __ATOMIC_RELAXED, __HIP_MEMORY_SCOPE_AGENT) * (1.f / 1024.f) + EPS);
    }
    const f32x4 fg = *(const f32x4*)(fgain + bcol + lane * 4);
#pragma unroll
    for (int ai = 0; ai < 2; ++ai) {
      float* ob = out + (size_t)(brow + ai * HALF + wid * 16) * 1024 + bcol + lane * 4;
#pragma unroll
      for (int i = 0; i < 16; ++i) __builtin_nontemporal_store(Y[ai][i] * __shfl(rn[ai], i) * fg, (f32x4*)(ob + (size_t)i * 1024));
    }
  }
};

DI void gemm1_phase(const Params& p) {
  for (int i = 0;; ++i) {
    int pm, pn; if (!tile_order(i, gridDim.x, blockIdx.x, NTOK / BM, NP / BM, pm, pn)) break;
    const int vmode = (pn == 2 || pn == 3) ? 1 : ((pn == 10 || pn == 11) ? 2 : 0);
    const bf16_t* A = vmode ? p.winT : p.h; const bf16_t* Bt = vmode ? p.h : p.winT;
    const int brow = vmode ? pn * BM : pm * BM, bcol = vmode ? pm * BM : pn * BM;
    gemm_tile(A, Bt, 1024, brow, bcol, EpiProj{p.proj, p.gvT, p.dvT, vmode});
  }
}
DI void gemm2_phase(const Params& p) {
  for (int i = 0;; ++i) {
    int pm, pn; if (!tile_order(i, gridDim.x, blockIdx.x, NTOK / BM, 1024 / BM, pm, pn)) break;
    gemm_tile(p.mix, p.woutT, 1024, pm * BM, pn * BM, EpiOut{p.x, p.mod, p.final_gain, p.out, p.rowsq, p.pcnt});
  }
}

DI float lam_value(const Params& p, const int t) {
  const int i = t & 63;
  const float s1 = wave_sum(p.lq1[i] * p.lk1[i]), s2 = wave_sum(p.lq2[i] * p.lk2[i]);
  return __expf(s1) - __expf(s2) + 0.2f;
}

#define LBAR() do { asm volatile("s_waitcnt lgkmcnt(0)" ::: "memory"); __builtin_amdgcn_s_barrier(); asm volatile("" ::: "memory"); } while (0)

typedef float f32x16 __attribute__((ext_vector_type(16)));
#define MFMA32(a, b, c) __builtin_amdgcn_mfma_f32_32x32x16_bf16((a), (b), (c), 0, 0, 0)
constexpr int AT_KB = 16384, AT_VB = 16384, AT_BUF = AT_KB + AT_VB;

DI bf16x8 pack8(const f32x16& x, int s) {
  u32x4 p; p.x = pk_bf16(x[8 * s], x[8 * s + 1]); p.y = pk_bf16(x[8 * s + 2], x[8 * s + 3]); p.z = pk_bf16(x[8 * s + 4], x[8 * s + 5]); p.w = pk_bf16(x[8 * s + 6], x[8 * s + 7]);
  return __builtin_bit_cast(bf16x8, p);
}
DI int swap23(int x) { return (x & ~12) | ((x & 4) << 1) | ((x & 8) >> 1); }

constexpr int AT_K0 = 0, AT_V0 = 49152;
DI void attn_item(const Params& p, const int bh, const int qb, const float lam, unsigned char* smem, const int t) {
  const int lane = t & 63, wid = t >> 6, r32 = lane & 31, hl = lane >> 5;
  const int qg = wid & 3, mp = wid >> 2;
  const int b = bh >> 2, hd = bh & 3;
  const size_t tokb = (size_t)b * SEQ;
  const int q0 = qb * 128 + qg * 32, iq = q0 + r32;
  const float slope2 = exp2f(-2.f * (hd + 1)) * 1.44269504f;
  const f32x2 c1v = {0.125f * 1.44269504f, 0.125f * 1.44269504f};
  bf16x8 qf[4];
  {
    const bf16_t* qp = p.proj + (tokb + iq) * NP + C_DQ + hd * 128 + mp * 64 + hl * 8;
#pragma unroll
    for (int sl = 0; sl < 4; ++sl) qf[sl] = *(const bf16x8*)(qp + sl * 16);
  }
  f32x2 kb[8];
#pragma unroll
  for (int i = 0; i < 8; ++i) { const int kof = 16 * ((2 * i) >> 3) + ((2 * i) & 7) + 8 * hl; kb[i] = (f32x2){slope2 * (float)kof, slope2 * (float)(kof + 1)}; }
  f32x16 O[4];
#pragma unroll
  for (int dt = 0; dt < 4; ++dt)
#pragma unroll
    for (int r = 0; r < 16; ++r) O[dt][r] = 0.f;
  float mrun = 0.f, lrun = 0.f;
  const int L0 = wid * 128 + lane, L1 = L0 + 64;
  const int kr0 = L0 >> 4, kr1 = L1 >> 4;
  const bf16_t* kg0 = p.proj + (tokb + kr0) * NP + C_DK + hd * 128 + (((L0 & 15) ^ (kr0 & 15)) << 3);
  const bf16_t* kg1 = p.proj + (tokb + kr1) * NP + C_DK + hd * 128 + (((L1 & 15) ^ (kr1 & 15)) << 3);
  const int vr0 = L0 >> 3, vr1 = L1 >> 3;
  const bf16_t* vg0 = p.dvT + ((size_t)bh * 128 + vr0) * SEQ + (((L0 & 7) ^ ((vr0 >> 1) & 7)) << 3);
  const bf16_t* vg1 = p.dvT + ((size_t)bh * 128 + vr1) * SEQ + (((L1 & 7) ^ ((vr1 >> 1) & 7)) << 3);
  const unsigned wslot = wid * 2048;
#define AT_STAGE(kbo, vbo, jt_) do { \
    __builtin_amdgcn_global_load_lds((const unsigned*)(kg0 + (size_t)(jt_) * 64 * NP), (unsigned*)(smem + (kbo) + wslot), 16, 0, 0); \
    __builtin_amdgcn_global_load_lds((const unsigned*)(kg1 + (size_t)(jt_) * 64 * NP), (unsigned*)(smem + (kbo) + wslot + 1024), 16, 0, 0); \
    __builtin_amdgcn_global_load_lds((const unsigned*)(vg0 + (jt_) * 64), (unsigned*)(smem + (vbo) + wslot), 16, 0, 0); \
    __builtin_amdgcn_global_load_lds((const unsigned*)(vg1 + (jt_) * 64), (unsigned*)(smem + (vbo) + wslot + 1024), 16, 0, 0); } while (0)
  const int krow = swap23(r32);
  const unsigned kread = (krow * 256) | ((((krow & 15) ^ hl) << 4) ^ (mp << 7));
  const unsigned vread = r32 * 128 + ((hl ^ ((r32 >> 1) & 7)) << 4);
  const int nt = 2 * qb + 2, wnt = 2 * qb + (qg >> 1) + 1;
#define AT_QK(kbuf_) do { \
    bf16x8 kq0[4], kq1[4]; \
    _Pragma("unroll") for (int sl = 0; sl < 4; ++sl) { \
      kq0[sl] = *(const bf16x8*)((kbuf_) + (kread ^ (unsigned)((sl * 2) << 4))); \
      kq1[sl] = *(const bf16x8*)((kbuf_) + 8192 + (kread ^ (unsigned)((sl * 2) << 4))); } \
    _Pragma("unroll") for (int r = 0; r < 16; ++r) { S0[r] = 0.f; S1[r] = 0.f; } \
    __builtin_amdgcn_sched_barrier(0); \
    _Pragma("unroll") for (int sl = 0; sl < 4; ++sl) { S0 = MFMA32(kq0[sl], qf[sl], S0); S1 = MFMA32(kq1[sl], qf[sl], S1); } } while (0)
#define AT_SOFTMAX(DIAG) do { \
    const int dj = jt * 64 + 8 * hl - iq; \
    const float dls = slope2 * (float)(jt * 64 - iq) - mrun; \
    const f32x2 dl0 = {dls, dls}, dl1 = {dls + slope2 * 32.f, dls + slope2 * 32.f}; \
    float mx = -1e30f; \
    _Pragma("unroll") for (int i = 0; i < 8; ++i) { \
      const int kof = 16 * ((2 * i) >> 3) + ((2 * i) & 7); \
      f32x2 u0 = (f32x2){S0[2 * i], S0[2 * i + 1]} * c1v + (kb[i] + dl0), u1 = (f32x2){S1[2 * i], S1[2 * i + 1]} * c1v + (kb[i] + dl1); \
      if (DIAG) { if (dj + kof > 0) u0.x = -1e30f; if (dj + kof + 1 > 0) u0.y = -1e30f; if (dj + 32 + kof > 0) u1.x = -1e30f; if (dj + 33 + kof > 0) u1.y = -1e30f; } \
      S0[2 * i] = u0.x; S0[2 * i + 1] = u0.y; S1[2 * i] = u1.x; S1[2 * i + 1] = u1.y; \
      mx = fmaxf(fmaxf(mx, u0.x), fmaxf(u0.y, fmaxf(u1.x, u1.y))); } \
    mx = fmaxf(mx, __shfl_xor(mx, 32)); \
    live = first || !__all(mx < -60.f);     \
    if (!live) break; \
    if (__any(mx > 8.f) || first) { \
      const float inc = first ? mx : fmaxf(mx, 0.f), al = first ? 0.f : __builtin_amdgcn_exp2f(-inc);     \
      mrun += inc; lrun *= al; \
      _Pragma("unroll") for (int dt = 0; dt < 4; ++dt) _Pragma("unroll") for (int r = 0; r < 16; ++r) O[dt][r] *= al; \
      _Pragma("unroll") for (int r = 0; r < 16; ++r) { S0[r] -= inc; S1[r] -= inc; } } \
    f32x2 ls2 = {0.f, 0.f}; \
    _Pragma("unroll") for (int i = 0; i < 8; ++i) { \
      const f32x2 p0 = {__builtin_amdgcn_exp2f(S0[2 * i]), __builtin_amdgcn_exp2f(S0[2 * i + 1])}, p1 = {__builtin_amdgcn_exp2f(S1[2 * i]), __builtin_amdgcn_exp2f(S1[2 * i + 1])}; \
      S0[2 * i] = p0.x; S0[2 * i + 1] = p0.y; S1[2 * i] = p1.x; S1[2 * i + 1] = p1.y; ls2 += p0 + p1; } \
    lrun += ls2.x + ls2.y; \
    pf[0] = pack8(S0, 0); pf[1] = pack8(S0, 1); pf[2] = pack8(S1, 0); pf[3] = pack8(S1, 1); } while (0)
#define AT_VLD(dst, vbuf_, ks) _Pragma("unroll") for (int dt = 0; dt < 4; ++dt) dst[dt] = *(const bf16x8*)((vbuf_) + dt * 4096 + (vread ^ (unsigned)((ks) << 5)))
#define AT_VMM(src, ks) _Pragma("unroll") for (int dt = 0; dt < 4; ++dt) O[dt] = MFMA32(src[dt], pf[ks], O[dt])
#define AT_PV(vbuf_) do { \
    bf16x8 va[4], vb[4]; \
    AT_VLD(va, vbuf_, 0); AT_VLD(vb, vbuf_, 1); \
    __builtin_amdgcn_sched_barrier(0); \
    __builtin_amdgcn_s_setprio(1); \
    AT_VMM(va, 0); AT_VLD(va, vbuf_, 2); \
    __builtin_amdgcn_sched_barrier(0); \
    AT_VMM(vb, 1); AT_VLD(vb, vbuf_, 3); \
    __builtin_amdgcn_sched_barrier(0); \
    AT_VMM(va, 2); AT_VMM(vb, 3); \
    __builtin_amdgcn_s_setprio(0); } while (0)
  f32x16 S0, S1;
  bf16x8 pf[4];
  int kcur = 0;
  bool live = false, pend = false;
  __syncthreads();
  AT_STAGE(AT_K0, AT_V0, nt - 1);
  AT_STAGE(AT_K0 + 16384, AT_V0 + 16384, nt - 2);
  asm volatile("s_waitcnt vmcnt(4)" ::: "memory");
  LBAR();
  for (int it = 0; it < nt; ++it) {
    const int jt = nt - 1 - it;
    const bool first = (jt == wnt - 1);
    unsigned char* kbuf = smem + AT_K0 + kcur * 16384;
    unsigned char* vbuf = smem + AT_V0 + (it & 3) * 16384;
    const int k2 = (kcur == 0) ? 2 : kcur - 1;
    if (it + 2 < nt) AT_STAGE(AT_K0 + k2 * 16384, AT_V0 + ((it + 2) & 3) * 16384, jt - 2);
    if (mp == 0) {
      if (jt < wnt) {
        AT_QK(kbuf);
        if (jt * 64 + 63 > q0) AT_SOFTMAX(1); else AT_SOFTMAX(0);
        if (live) AT_PV(vbuf);
      }
    } else {
      if (jt < wnt) AT_QK(kbuf);
      if (pend) AT_PV(smem + AT_V0 + ((it - 1) & 3) * 16384);
      pend = false;
      if (jt < wnt) { if (jt * 64 + 63 > q0) AT_SOFTMAX(1); else AT_SOFTMAX(0); pend = live; }
    }
    kcur = (kcur == 2) ? 0 : kcur + 1;
    if (it + 2 < nt) asm volatile("s_waitcnt vmcnt(4)" ::: "memory"); else asm volatile("s_waitcnt vmcnt(0)" ::: "memory");
    LBAR();
  }
  if (mp == 1 && pend) AT_PV(smem + AT_V0 + ((nt - 1) & 3) * 16384);
  __syncthreads();
#undef AT_STAGE
#undef AT_QK
#undef AT_SOFTMAX
#undef AT_PV
#undef AT_VLD
#undef AT_VMM
  const float lt = lrun + __shfl_xor(lrun, 32);
  const float sc = (mp ? lam : 1.f) / lt;
  float* xch = (float*)(smem + qg * 16384);
  if (mp == 1) {
#pragma unroll
    for (int dt = 0; dt < 4; ++dt)
#pragma unroll
      for (int g = 0; g < 4; ++g)
        *(f32x4*)(xch + ((dt * 4 + g) * 64 + lane) * 4) = (f32x4){O[dt][4 * g] * sc, O[dt][4 * g + 1] * sc, O[dt][4 * g + 2] * sc, O[dt][4 * g + 3] * sc};
  }
  __syncthreads();
  if (mp == 0) {
    float ss = 0.f;
#pragma unroll
    for (int dt = 0; dt < 4; ++dt)
#pragma unroll
      for (int g = 0; g < 4; ++g) {
        const f32x4 o2 = *(const f32x4*)(xch + ((dt * 4 + g) * 64 + lane) * 4);
#pragma unroll
        for (int j = 0; j < 4; ++j) { const float o = O[dt][4 * g + j] * sc - o2[j]; O[dt][4 * g + j] = o; ss += o * o; }
      }
    ss += __shfl_xor(ss, 32);
    const float rn = rsqrtf(ss * (1.f / 128.f) + EPS) * 0.8f;
    const bf16_t* zp = p.proj + (tokb + iq) * NP + C_DZ + hd * 128;
    bf16_t* mo = p.mix + (tokb + iq) * 1024 + 512 + hd * 128;
    const float* gp = p.diff_gain + hd * 128 + 4 * hl;
#pragma unroll
    for (int dt = 0; dt < 4; ++dt)
#pragma unroll
      for (int gp2 = 0; gp2 < 2; ++gp2) {
        const int dvw = dt * 32 + 8 * (2 * gp2 + hl);
        const u32x4 z16 = *(const u32x4*)(zp + dvw);
        unsigned zx0 = z16.x, zy0 = z16.y, zx1 = z16.z, zy1 = z16.w;
        swap32(zx0, zx1); swap32(zy0, zy1);
        unsigned wx[2], wy[2];
#pragma unroll
        for (int q = 0; q < 2; ++q) {
          const int g = 2 * gp2 + q; const int dv = dt * 32 + 8 * g;
          const f32x4 gn = *(const f32x4*)(gp + dv);
          const unsigned zx = q ? zx1 : zx0, zy = q ? zy1 : zy0;
          const float y0 = O[dt][4 * g + 0] * rn * gn[0] * bf_lo(zx), y1 = O[dt][4 * g + 1] * rn * gn[1] * bf_hi(zx);
          const float y2 = O[dt][4 * g + 2] * rn * gn[2] * bf_lo(zy), y3 = O[dt][4 * g + 3] * rn * gn[3] * bf_hi(zy);
          wx[q] = pk_bf16(y0, y1); wy[q] = pk_bf16(y2, y3);
        }
        swap32(wx[0], wx[1]); swap32(wy[0], wy[1]);
        *(u32x4*)(mo + dvw) = (u32x4){wx[0], wy[0], wx[1], wy[1]};
      }
  }
}

constexpr int GL_QIN = 0, GL_KIN = 8192, GL_KST = 16384, GL_DEC = 24576, GL_CS = 24832, GL_XST = 26880, GL_OSQ = 43264, GL_PF = 44288;
constexpr int GP_VT = 0, GP_Q = 16384, GP_K = 24576, GP_LA = 32768, GP_SZ = 49152;
DI unsigned sw128(int row, int chunk) { return (unsigned)(row * 128 + ((chunk ^ ((row >> 1) & 7)) << 4)); }

DI void gla_item(const Params& p, const int bh, unsigned char* smem, const int t) {
  const int lane = t & 63, wid = t >> 6, r32 = lane & 31, hl = lane >> 5;
  const int vt = wid & 3, kt = wid >> 2, it = kt;
  const int b = bh >> 2, hd = bh & 3;
  const size_t tokb = (size_t)b * SEQ;
  const int d = lane, jg = wid, col = hd * 64 + d;
  f32x16 St;
#pragma unroll
  for (int r = 0; r < 16; ++r) St[r] = 0.f;
  const int L0 = wid * 128 + lane, L1 = L0 + 64, vr0 = L0 >> 3, vr1 = L1 >> 3;
  const bf16_t* vg0 = p.gvT + ((size_t)bh * 128 + vr0) * SEQ + (((L0 & 7) ^ ((vr0 >> 1) & 7)) << 3);
  const bf16_t* vg1 = p.gvT + ((size_t)bh * 128 + vr1) * SEQ + (((L1 & 7) ^ ((vr1 >> 1) & 7)) << 3);
  const int Lq = wid * 64 + lane;
  const bf16_t* qg = p.proj + (tokb + (Lq >> 3)) * NP + C_GQ + hd * 64 + (Lq & 7) * 8;
  const bf16_t* kg = p.proj + (tokb + (Lq >> 3)) * NP + C_GK + hd * 64 + (Lq & 7) * 8;
  const int La0 = wid * 128 + lane, La1 = La0 + 64;
  const float* lag0 = p.la + (tokb + (La0 >> 4)) * 256 + hd * 64 + (La0 & 15) * 4;
  const float* lag1 = p.la + (tokb + (La1 >> 4)) * 256 + hd * 64 + (La1 & 15) * 4;
#define GL_STAGE(bufo, ch_) do { \
    __builtin_amdgcn_global_load_lds((const unsigned*)(vg0 + (ch_) * 64), (unsigned*)(smem + (bufo) + GP_VT + wid * 2048), 16, 0, 0); \
    __builtin_amdgcn_global_load_lds((const unsigned*)(vg1 + (ch_) * 64), (unsigned*)(smem + (bufo) + GP_VT + wid * 2048 + 1024), 16, 0, 0); \
    __builtin_amdgcn_global_load_lds((const unsigned*)(qg + (size_t)(ch_) * 64 * NP), (unsigned*)(smem + (bufo) + GP_Q + wid * 1024), 16, 0, 0); \
    __builtin_amdgcn_global_load_lds((const unsigned*)(kg + (size_t)(ch_) * 64 * NP), (unsigned*)(smem + (bufo) + GP_K + wid * 1024), 16, 0, 0); \
    __builtin_amdgcn_global_load_lds((const unsigned*)(lag0 + (size_t)(ch_) * 64 * 256), (unsigned*)(smem + (bufo) + GP_LA + wid * 2048), 16, 0, 0); \
    __builtin_amdgcn_global_load_lds((const unsigned*)(lag1 + (size_t)(ch_) * 64 * 256), (unsigned*)(smem + (bufo) + GP_LA + wid * 2048 + 1024), 16, 0, 0); } while (0)
  const int krow = swap23(r32);
  const int qi = it * 32 + r32;
  float* cs = (float*)(smem + GL_CS); float* dec = (float*)(smem + GL_DEC); float* osq = (float*)(smem + GL_OSQ);
  const int v0 = hd * 128 + vt * 32 + 4 * hl;
  f32x4 gnv[4];
#pragma unroll
  for (int g = 0; g < 4; ++g) gnv[g] = *(const f32x4*)(p.gla_gain + v0 + 8 * g);
  __syncthreads();
  GL_STAGE(GL_PF, 0);
  asm volatile("s_waitcnt vmcnt(0)" ::: "memory");
  __syncthreads();
  for (int ch = 0; ch < SEQ / 64; ++ch) {
    const size_t tok0 = tokb + (size_t)ch * 64;
    unsigned char* pb = smem + GL_PF + (ch & 1) * GP_SZ;
    if (ch + 1 < SEQ / 64) GL_STAGE(GL_PF + ((ch + 1) & 1) * GP_SZ, ch + 1);
    const bf16_t* zp = p.proj + (tok0 + qi) * NP + C_GZ + v0;
    u32x2 zz[4];
#pragma unroll
    for (int g = 0; g < 4; ++g) zz[g] = *(const u32x2*)(zp + 8 * g);
    float la[8], qv[8], kv[8];
    {
      float run = 0.f;
#pragma unroll
      for (int e = 0; e < 8; ++e) {
        const int j = jg * 8 + e;
        run += *(const float*)(pb + GP_LA + j * 256 + d * 4); la[e] = run;
        qv[e] = bf2f(*(const bf16_t*)(pb + GP_Q + j * 128 + d * 2)); kv[e] = bf2f(*(const bf16_t*)(pb + GP_K + j * 128 + d * 2));
      }
      cs[jg * 64 + d] = run;
    }
    LBAR();
    {
      float pre = 0.f, tot = 0.f;
#pragma unroll
      for (int g = 0; g < 8; ++g) { const float c = cs[g * 64 + d]; tot += c; if (g < jg) pre += c; }
      const float etot = __builtin_amdgcn_exp2f(tot * 1.44269504f);
      float ks[8];
#pragma unroll
      for (int e = 0; e < 8; ++e) {
        const int j = jg * 8 + e; const float bc = pre + la[e];
        const float eb = __builtin_amdgcn_exp2f(bc * 1.44269504f), ib = __builtin_amdgcn_rcpf(eb);
        const float qin = qv[e] * 0.125f * eb, kin = kv[e] * ib;
        ks[e] = kin * etot;
        const unsigned off = sw128(j, d >> 3) + ((d & 7) << 1);
        *(bf16_t*)(smem + GL_QIN + off) = (bf16_t)(pk_bf16(qin, 0.f) & 0xffff);
        *(bf16_t*)(smem + GL_KIN + off) = (bf16_t)(pk_bf16(kin, 0.f) & 0xffff);
      }
      u32x4 w; w.x = pk_bf16(ks[0], ks[1]); w.y = pk_bf16(ks[2], ks[3]); w.z = pk_bf16(ks[4], ks[5]); w.w = pk_bf16(ks[6], ks[7]);
      *(u32x4*)(smem + GL_KST + sw128(d, jg)) = w;
      if (jg == 0) dec[d] = etot;
      *(bf16x8*)(smem + GL_XST + ((wid * 2 + 0) * 64 + lane) * 16) = pack8(St, 0);
      *(bf16x8*)(smem + GL_XST + ((wid * 2 + 1) * 64 + lane) * 16) = pack8(St, 1);
    }
    LBAR();
    f32x16 Oacc;
#pragma unroll
    for (int r = 0; r < 16; ++r) Oacc[r] = 0.f;
#pragma unroll
    for (int js = 0; js < 2; ++js) {
      if (js > it) continue;
      f32x16 S;
#pragma unroll
      for (int r = 0; r < 16; ++r) S[r] = 0.f;
#pragma unroll
      for (int sl = 0; sl < 4; ++sl) {
        const bf16x8 af = *(const bf16x8*)(smem + GL_KIN + sw128(js * 32 + krow, sl * 2 + hl));
        const bf16x8 bq = *(const bf16x8*)(smem + GL_QIN + sw128(qi, sl * 2 + hl));
        S = MFMA32(af, bq, S);
      }
      if (js == it) {
#pragma unroll
        for (int r = 0; r < 16; ++r) { const int kof = 16 * (r >> 3) + (r & 7) + 8 * hl; if (kof > r32) S[r] = 0.f; }
      }
      const bf16x8 pf0 = pack8(S, 0), pf1 = pack8(S, 1);
      const bf16x8 va = *(const bf16x8*)(pb + GP_VT + sw128(vt * 32 + r32, js * 4 + 0 + hl));
      const bf16x8 vb = *(const bf16x8*)(pb + GP_VT + sw128(vt * 32 + r32, js * 4 + 2 + hl));
      Oacc = MFMA32(va, pf0, Oacc); Oacc = MFMA32(vb, pf1, Oacc);
    }
#pragma unroll
    for (int kk = 0; kk < 2; ++kk)
#pragma unroll
      for (int s2 = 0; s2 < 2; ++s2) {
        const bf16x8 sf = *(const bf16x8*)(smem + GL_XST + (((kk * 4 + vt) * 2 + s2) * 64 + lane) * 16);
        const bf16x8 bq = *(const bf16x8*)(smem + GL_QIN + sw128(qi, kk * 4 + s2 * 2 + hl));
        Oacc = MFMA32(sf, bq, Oacc);
      }
    {
      const float* dp = dec + kt * 32 + 8 * hl;
      const f32x4 d0 = *(const f32x4*)(dp), d1 = *(const f32x4*)(dp + 4), d2 = *(const f32x4*)(dp + 16), d3 = *(const f32x4*)(dp + 20);
#pragma unroll
      for (int j = 0; j < 4; ++j) { St[j] *= d0[j]; St[4 + j] *= d1[j]; St[8 + j] *= d2[j]; St[12 + j] *= d3[j]; }
#pragma unroll
      for (int ks = 0; ks < 4; ++ks) {
        const bf16x8 af = *(const bf16x8*)(smem + GL_KST + sw128(kt * 32 + krow, ks * 2 + hl));
        const bf16x8 bv = *(const bf16x8*)(pb + GP_VT + sw128(vt * 32 + r32, ks * 2 + hl));
        St = MFMA32(af, bv, St);
      }
    }
    {
      float ss = 0.f;
#pragma unroll
      for (int r = 0; r < 16; ++r) ss += Oacc[r] * Oacc[r];
      ss += __shfl_xor(ss, 32);
      if (hl == 0) osq[vt * 64 + qi] = ss;
    }
    asm volatile("s_waitcnt vmcnt(0)" ::: "memory");
    LBAR();
    {
      const float tot = osq[qi] + osq[64 + qi] + osq[128 + qi] + osq[192 + qi];
      const float rn = rsqrtf(tot * (1.f / 128.f) + EPS);
      bf16_t* mo = p.mix + (tok0 + qi) * 1024 + v0;
#pragma unroll
      for (int g = 0; g < 4; ++g) {
        const f32x4 gn = gnv[g];
        const float y0 = Oacc[4 * g + 0] * rn * gn[0] * bf_lo(zz[g].x), y1 = Oacc[4 * g + 1] * rn * gn[1] * bf_hi(zz[g].x);
        const float y2 = Oacc[4 * g + 2] * rn * gn[2] * bf_lo(zz[g].y), y3 = Oacc[4 * g + 3] * rn * gn[3] * bf_hi(zz[g].y);
        u32x2 w; w.x = pk_bf16(y0, y1); w.y = pk_bf16(y2, y3);
        *(u32x2*)(mo + 8 * g) = w;
      }
    }
  }
#undef GL_STAGE
}

DI void mixer_phase(const Params& p, unsigned char* smem, const int t, const int cidx = 0, const int first = 0, const int limit = 100000) {
  const float lam = lam_value(p, t);
  constexpr int N_GLA = 64, N_ATT = 64 * 16;
  volatile int* sitem = (volatile int*)(smem + LDS_BYTES - 16);
  for (;;) {
    __syncthreads();
    if (t == 0) *sitem = first + (int)atomicAdd(p.ctr + cidx, 1u);
    __syncthreads();
    const int item = *sitem;
    if (item >= N_GLA + N_ATT || item >= limit) break;
#ifndef NO_GLA
    if (item < N_GLA) gla_item(p, item, smem, fresh_tid());
#endif
#ifndef NO_ATT
    if (item >= N_GLA) { const int a = item - N_GLA; attn_item(p, a & 63, 15 - (a >> 6), lam, smem, fresh_tid()); }
#endif
  }
}

DI void final_phase(const Params& p, const int t) {
  const size_t n4 = (size_t)NTOK * 1024 / 4;
  for (size_t i = (size_t)blockIdx.x * NTHREADS + t; i < n4; i += (size_t)gridDim.x * NTHREADS) {
    const size_t row = i >> 8; const int c4 = (int)(i & 255) * 4;
    const float r = rsqrtf(p.rowsq[row] * (1.f / 1024.f) + EPS);
    const f32x4 y = *(const f32x4*)(p.out + i * 4), gv = *(const f32x4*)(p.final_gain + c4);
    *(f32x4*)(p.out + i * 4) = y * r * gv;
  }
}

typedef const __attribute__((address_space(4))) Params* ParamsK;
DI Params fresh_params() {
#if defined(__HIP_DEVICE_COMPILE__)
  ParamsK kp = (ParamsK)__builtin_amdgcn_kernarg_segment_ptr(); asm volatile("" : "+s"(kp));
  Params r; __builtin_memcpy_inline(&r, kp, sizeof(Params)); return r;
#else
  return Params{};
#endif
}

__global__ void __launch_bounds__(NTHREADS, 2) fwd_kernel(Params p_) {
  extern __shared__ __attribute__((aligned(16))) unsigned char smem[];
  cg::grid_group grid = cg::this_grid();
  const int lo = p_.phase_lo, hi = p_.phase_hi;
  if (hi == 99) grid.sync();
  volatile LAS unsigned* st = (volatile LAS unsigned*)(smem + LDS_BYTES - 32);
  if (lo < hi) {
    if (threadIdx.x == 0) { st[0] = 0u; st[1] = 0u; (void)xb_add(&p_.bar[XB_XCNT(xb_xcc_id())], 1u); }
    __syncthreads();
  }
#define SEAM(a_) do { if (lo <= (a_) && (a_) + 1 <= hi) { const Params pb = fresh_params(); xcd_barrier(pb.bar, st); } } while (0)
#ifndef PHM
#define PHM 63
#endif
  if ((PHM & 1) && lo <= 0 && 0 <= hi) { const Params p = fresh_params(); phase0a(p, smem, fresh_tid()); }
  SEAM(0);
  if ((PHM & 2) && lo <= 1 && 1 <= hi) { const Params p = fresh_params(); phase0b(p, smem, fresh_tid()); }
  SEAM(1);
  if ((PHM & 4) && lo <= 2 && 2 <= hi) { const Params p = fresh_params(); gemm1_phase(p); }
  SEAM(2);
  if ((PHM & 8) && lo <= 3 && 3 <= hi) { const Params p = fresh_params(); mixer_phase(p, smem, fresh_tid()); }
  SEAM(3);
  if ((PHM & 16) && lo <= 4 && 4 <= hi) { const Params p = fresh_params(); gemm2_phase(p); }
}

extern "C" void kernel_launch(void* const* d_in, const int* in_sizes, int n_in, void* d_out, int out_size, void* d_ws, size_t ws_size, hipStream_t stream) {
  static int grid_blocks = 0;
  if (!grid_blocks) {
    hipFuncSetAttribute((const void*)fwd_kernel, hipFuncAttributeMaxDynamicSharedMemorySize, LDS_BYTES);
    int dev = 0, cus = 0, per_cu = 0;
    hipGetDevice(&dev);
    hipDeviceGetAttribute(&cus, hipDeviceAttributeMultiprocessorCount, dev);
    hipOccupancyMaxActiveBlocksPerMultiprocessor(&per_cu, fwd_kernel, NTHREADS, LDS_BYTES);
    if (per_cu < 1) per_cu = 1;
    grid_blocks = cus * per_cu;
  }
  Params p{};
  p.x = (const float*)d_in[0]; p.c = (const float*)d_in[1]; p.w_ada = (const float*)d_in[2]; p.b_ada = (const float*)d_in[3];
  p.norm_gain = (const float*)d_in[4]; p.w_in = (const float*)d_in[5]; p.w_up = (const float*)d_in[6]; p.b_gate = (const float*)d_in[7];
  p.gla_gain = (const float*)d_in[8]; p.lq1 = (const float*)d_in[9]; p.lk1 = (const float*)d_in[10]; p.lq2 = (const float*)d_in[11];
  p.lk2 = (const float*)d_in[12]; p.diff_gain = (const float*)d_in[13]; p.w_out = (const float*)d_in[14]; p.final_gain = (const float*)d_in[15];
  p.out = (float*)d_out;
  unsigned char* w = (unsigned char*)d_ws; size_t off = 0;
  auto take = [&](size_t bytes) { void* r = w + off; off += (bytes + 255) & ~(size_t)255; return r; };
  p.modpart = (float*)take((size_t)8 * 16 * 3072 * 4);
  p.mod = (float*)take((size_t)16 * 3072 * 4);
  p.rowsq = (float*)take((size_t)NTOK * 4);
  p.la = (float*)take((size_t)NTOK * 256 * 4);
  p.winT = (bf16_t*)take((size_t)NP * 1024 * 2);
  p.woutT = (bf16_t*)take((size_t)1024 * 1024 * 2);
  p.h = (bf16_t*)take((size_t)NTOK * 1024 * 2);
  p.proj = (bf16_t*)take((size_t)NTOK * NP * 2);
  p.mix = (bf16_t*)take((size_t)NTOK * 1024 * 2);
  p.gvT = (bf16_t*)take((size_t)NTOK * 512 * 2);
  p.dvT = (bf16_t*)take((size_t)NTOK * 512 * 2);
  p.bar = (unsigned*)take((size_t)XCD_BAR_WORDS * 4 + 1024);
  p.ctr = p.bar + XCD_BAR_WORDS;
  p.pcnt = p.ctr + 64;
#if 0
  hipMemsetAsync(p.bar, 0, (size_t)XCD_BAR_WORDS * 4 + 1024, stream);
  for (int ph = 0; ph < 5; ++ph) {
    p.phase_lo = ph; p.phase_hi = ph;
    hipLaunchKernelGGL(fwd_kernel, dim3(grid_blocks), dim3(NTHREADS), LDS_BYTES, stream, p);
  }
#else
  p.phase_lo = 0; p.phase_hi = 4;
  hipMemsetAsync(p.bar, 0, (size_t)XCD_BAR_WORDS * 4 + 1024, stream);
  void* args[] = {&p};
  hipError_t e = hipLaunchCooperativeKernel((void*)fwd_kernel, dim3(grid_blocks), dim3(NTHREADS), args, LDS_BYTES, stream);
  if (e != hipSuccess) fprintf(stderr, "cooperative launch failed: %s (grid %d)\n", hipGetErrorString(e), grid_blocks);
#endif
}
```
